# Optimizing an MI355X kernel written in HIP

```python
import jax, jax.numpy as jnp
from jax import lax
import numpy as np

D_MODEL = 2048
BATCH = 4
SEQ = 4096
DEPTH = 1

CHUNK = 64
RET_HEADS = 8
RET_DK = D_MODEL // RET_HEADS
RET_DV = D_MODEL // RET_HEADS
HG_EXPAND = 128
HG_HEADS = D_MODEL // HG_EXPAND
HG_DK = HG_EXPAND
HG_DV = D_MODEL // HG_HEADS
N_SPLITS = 10
N_EXPERTS = 32
TOP_K = 4
D_FF = D_MODEL
SWIGLU_ALPHA = 1.702
SWIGLU_LIMIT = 7.0
EXPERT_BLOCK = 128
ROPE_BASE = 10000.0
EPS = 1e-6

kernel_name = "hybrid_retention_hgrn2_moe_block"


def rmsnorm(x, w):
    xf = x.astype(jnp.float32)
    y = xf * lax.rsqrt(jnp.mean(xf * xf, axis=-1, keepdims=True) + EPS) * w.astype(jnp.float32)
    return y.astype(x.dtype)


def head_norm(o, center):
    if center:
        o = o - jnp.mean(o, axis=-1, keepdims=True)
    return o * lax.rsqrt(jnp.mean(o * o, axis=-1, keepdims=True) + EPS)


def rotary(x):
    s, dh = x.shape[1], x.shape[3]
    inv = 1.0 / (ROPE_BASE ** jnp.linspace(0.0, 1.0, dh // 2, dtype=jnp.float32))
    ang = jnp.arange(s, dtype=jnp.float32)[:, None] * inv[None, :]
    cos = jnp.cos(ang)[None, :, None, :]
    sin = jnp.sin(ang)[None, :, None, :]
    x1, x2 = x[..., : dh // 2], x[..., dh // 2:]
    return jnp.concatenate([x1 * cos - x2 * sin, x2 * cos + x1 * sin], axis=-1)


def retention(q, k, v):
    b, s, h, dk = q.shape
    dv = v.shape[-1]
    nc = s // CHUNK
    log_gamma = jnp.log1p(-jnp.exp2(-5.0 - jnp.arange(h, dtype=jnp.float32)))
    q = rotary(q)
    k = rotary(k) * (dk ** -0.5)
    qc = q.reshape(b, nc, CHUNK, h, dk)
    kc = k.reshape(b, nc, CHUNK, h, dk)
    vc = v.reshape(b, nc, CHUNK, h, dv)
    pos = jnp.arange(CHUNK, dtype=jnp.float32)
    dist = jnp.abs(pos[:, None] - pos[None, :])
    decay_in = jnp.exp(dist[None] * log_gamma[:, None, None])
    scores = jnp.einsum('bnqhd,bnkhd->bnhqk', qc, kc) * decay_in
    intra = jnp.einsum('bnhqk,bnkhe->bnqhe', scores, vc)
    xi = jnp.exp((pos[:, None] + 1.0) * log_gamma[None])
    zeta = jnp.exp((CHUNK - 1.0 - pos)[:, None] * log_gamma[None])
    gamma_c = jnp.exp(CHUNK * log_gamma)

    def step(state, inp):
        q_n, k_n, v_n = inp
        out = jnp.einsum('bqhd,bhde->bqhe', q_n * xi[None, :, :, None], state)
        state = gamma_c[None, :, None, None] * state + jnp.einsum(
            'bkhd,bkhe->bhde', k_n * zeta[None, :, :, None], v_n)
        return state, out

    state0 = jnp.zeros((b, h, dk, dv), jnp.float32)
    _, inter = lax.scan(step, state0, (jnp.moveaxis(qc, 1, 0), jnp.moveaxis(kc, 1, 0), jnp.moveaxis(vc, 1, 0)))
    inter = jnp.moveaxis(inter, 0, 1)
    return (intra + inter).reshape(b, s, h, dv)


def hgrn2(q, f_logit, i, lb):
    b, s, h, dk = q.shape
    dv = i.shape[-1]
    nc = s // CHUNK
    q = jax.nn.silu(q)
    log_f = jnp.log(lb + (1.0 - lb) * jax.nn.sigmoid(f_logit))
    k = (1.0 - lb) * jax.nn.sigmoid(-f_logit)
    to_c = lambda a: jnp.moveaxis(a.reshape(b, nc, CHUNK, h, a.shape[-1]), 1, 0)
    pos = jnp.arange(CHUNK)
    causal = (pos[:, None] >= pos[None, :])[None, :, :, None, None]

    def step(state, inp):
        q_n, k_n, v_n, lf_n = inp
        cum = jnp.cumsum(lf_n, axis=1)
        diff = cum[:, :, None] - cum[:, None, :]
        decay = jnp.where(causal, jnp.exp(jnp.minimum(diff, 0.0)), 0.0)
        scores = jnp.einsum('bjmhd,bjhd->bjmh', decay * k_n[:, None], q_n)
        intra = jnp.einsum('bjmh,bmhe->bjhe', scores, v_n)
        inter = jnp.einsum('bjhd,bhde->bjhe', q_n * jnp.exp(cum), state)
        last = cum[:, -1]
        state = jnp.exp(last)[..., None] * state + jnp.einsum(
            'bmhd,bmhe->bhde', k_n * jnp.exp(last[:, None] - cum), v_n)
        return state, intra + inter

    state0 = jnp.zeros((b, h, dk, dv), jnp.float32)
    _, out = lax.scan(step, state0, (to_c(q), to_c(k), to_c(i), to_c(log_f)))
    return jnp.moveaxis(out, 0, 1).reshape(b, s, h, dv)


def mixer(hn, w_in, ret_norm_w, hg_norm_w, lb, w_out):
    b, s, _ = hn.shape
    z = hn @ w_in
    parts = [p.astype(jnp.float32) for p in jnp.split(z, N_SPLITS, axis=-1)]
    rq, rk, rv, rg, hq, hf, hi, hg, gate_r, gate_h = parts
    heads = lambda a, n: a.reshape(b, s, n, a.shape[-1] // n)
    o_r = retention(heads(rq, RET_HEADS), heads(rk, RET_HEADS), heads(rv, RET_HEADS))
    o_r = head_norm(o_r, True).reshape(b, s, D_MODEL) * ret_norm_w.astype(jnp.float32) * jax.nn.silu(rg)
    o_h = hgrn2(heads(hq, HG_HEADS), heads(hf, HG_HEADS), heads(hi, HG_HEADS), lb.reshape(HG_HEADS, HG_DK))
    o_h = head_norm(o_h, False).reshape(b, s, D_MODEL) * hg_norm_w.astype(jnp.float32) * jax.nn.silu(hg)
    merged = jax.nn.sigmoid(gate_r) * o_r + jax.nn.sigmoid(gate_h) * o_h
    return merged.astype(hn.dtype) @ w_out


def clamped_swiglu(hcat):
    x_glu = jnp.minimum(hcat[..., ::2], SWIGLU_LIMIT)
    x_lin = jnp.clip(hcat[..., 1::2], -SWIGLU_LIMIT, SWIGLU_LIMIT)
    return x_glu * jax.nn.sigmoid(SWIGLU_ALPHA * x_glu) * (x_lin + 1.0)


def moe(hn, w_router, b_router, w1, b1, w2, b2):
    b, s, d = hn.shape
    n = b * s
    xt = hn.reshape(n, d)
    logits = (xt @ w_router + b_router).astype(jnp.float32)
    top_vals, top_idx = lax.top_k(logits, TOP_K)
    gates = jax.nn.softmax(top_vals, axis=-1)
    e_flat = top_idx.reshape(-1)
    tok_flat = jnp.repeat(jnp.arange(n, dtype=jnp.int32), TOP_K)
    g_flat = gates.reshape(-1)
    order = jnp.argsort(e_flat)
    e_sorted, tok_sorted, g_sorted = e_flat[order], tok_flat[order], g_flat[order]
    counts = jnp.bincount(e_flat, length=N_EXPERTS)
    start = jnp.cumsum(counts) - counts
    padded = (counts + EXPERT_BLOCK - 1) // EXPERT_BLOCK * EXPERT_BLOCK
    end_pad = jnp.cumsum(padded)
    start_pad = end_pad - padded
    rank = jnp.arange(n * TOP_K, dtype=jnp.int32) - start[e_sorted]
    dest = start_pad[e_sorted] + rank
    m_pad = -(-(n * TOP_K) // EXPERT_BLOCK) * EXPERT_BLOCK + N_EXPERTS * EXPERT_BLOCK
    n_blocks = m_pad // EXPERT_BLOCK
    tok_pad = jnp.zeros((m_pad,), jnp.int32).at[dest].set(tok_sorted)
    g_pad = jnp.zeros((m_pad,), jnp.float32).at[dest].set(g_sorted)
    block_start = jnp.arange(n_blocks, dtype=jnp.int32) * EXPERT_BLOCK
    block_expert = jnp.minimum(jnp.sum(end_pad[None, :] <= block_start[:, None], axis=1), N_EXPERTS - 1)
    x_blocks = xt[tok_pad].reshape(n_blocks, EXPERT_BLOCK, d)

    def expert_block(args):
        xb, e = args
        hid = clamped_swiglu(xb @ w1[e] + b1[e])
        return hid @ w2[e] + b2[e]

    y_blocks = lax.map(expert_block, (x_blocks, block_expert))
    y_rows = y_blocks.reshape(m_pad, d).astype(jnp.float32) * g_pad[:, None]
    out = jax.ops.segment_sum(y_rows, tok_pad, num_segments=n)
    return out.reshape(b, s, d).astype(hn.dtype)


def setup_inputs(seed: int = 0) -> dict:
    key = jax.random.key(seed)
    ks = jax.random.split(key, 16)
    f32 = jnp.float32
    nrm = lambda k, shape, scale: jax.random.normal(k, shape, f32) * scale
    return {
        "x": nrm(ks[0], (BATCH, SEQ, D_MODEL), 1.0),
        "w_in": nrm(ks[1], (DEPTH, D_MODEL, N_SPLITS * D_MODEL), D_MODEL ** -0.5),
        "ret_norm_w": 1.0 + nrm(ks[2], (DEPTH, D_MODEL), 0.1),
        "hg_norm_w": 1.0 + nrm(ks[3], (DEPTH, D_MODEL), 0.1),
        "hg_lb_logits": nrm(ks[4], (DEPTH + 1, HG_HEADS * HG_DK), 0.1),
        "w_out": nrm(ks[5], (DEPTH, D_MODEL, D_MODEL), D_MODEL ** -0.5),
        "norm_mix_w": 1.0 + nrm(ks[6], (DEPTH, D_MODEL), 0.1),
        "norm_moe_w": 1.0 + nrm(ks[7], (DEPTH, D_MODEL), 0.1),
        "w_router": nrm(ks[8], (DEPTH, D_MODEL, N_EXPERTS), D_MODEL ** -0.5),
        "b_router": nrm(ks[9], (DEPTH, N_EXPERTS), 0.01),
        "w1": nrm(ks[10], (DEPTH, N_EXPERTS, D_MODEL, 2 * D_FF), D_MODEL ** -0.5),
        "b1": nrm(ks[11], (DEPTH, N_EXPERTS, 2 * D_FF), 0.01),
        "w2": nrm(ks[12], (DEPTH, N_EXPERTS, D_FF, D_MODEL), D_FF ** -0.5),
        "b2": nrm(ks[13], (DEPTH, N_EXPERTS, D_MODEL), 0.01),
        "norm_final_w": 1.0 + nrm(ks[14], (D_MODEL,), 0.1),
    }


def reference(x, w_in, ret_norm_w, hg_norm_w, hg_lb_logits, w_out, norm_mix_w, norm_moe_w,
              w_router, b_router, w1, b1, w2, b2, norm_final_w):
    lb_all = jnp.cumsum(jax.nn.softmax(hg_lb_logits.astype(jnp.float32), axis=0), axis=0)
    h = x
    for l in range(DEPTH):
        h = h + mixer(rmsnorm(h, norm_mix_w[l]), w_in[l], ret_norm_w[l], hg_norm_w[l], lb_all[l], w_out[l])
        h = h + moe(rmsnorm(h, norm_moe_w[l]), w_router[l], b_router[l], w1[l], b1[l], w2[l], b2[l])
    return rmsnorm(h, norm_final_w)
```

```cpp
#include <hip/hip_runtime.h>
#include <cstdio>
#include <cstdint>

#ifndef DBG_SKIP_MOE
#define DBG_SKIP_MOE 0
#endif
#ifndef DIAG
#define DIAG 0
#endif
#ifndef DIAG_THR
#define DIAG_THR 0.05f
#endif
#ifndef DIAG_SUB
#define DIAG_SUB 4
#endif
#ifndef DIAG_STAGE2
#define DIAG_STAGE2 3
#endif
#ifndef DIAG_STAGE
#define DIAG_STAGE 2
#endif
#ifndef N_LAUNCH_MODE
#define N_LAUNCH_MODE 1
#endif

#define LAS __attribute__((address_space(3)))
typedef unsigned short bf16_t;
typedef short bf16x8 __attribute__((ext_vector_type(8)));
typedef float f32x4 __attribute__((ext_vector_type(4)));
typedef unsigned u32x4 __attribute__((ext_vector_type(4)));
typedef unsigned u32x2 __attribute__((ext_vector_type(2)));

constexpr int NT = 16384, DM = 2048, NZ = 20480, SEQ = 4096, NE = 32, DFF = 2048;
constexpr int MAXROWS = 65536 + NE * 256;
constexpr int MAXMT = MAXROWS / 256;
constexpr int NTHREADS = 512;
constexpr int STAGE_LDS = 131072;
constexpr int MIX_LDS = 139776;
constexpr int XTRA_OFF = 140288;
constexpr int LDS_BYTES = XTRA_OFF + 4096;

#define XB_TMO      128
#define XB_XCNT(j)  (256  + 64 * (j))
#define XB_XSUB(j)  (1280 + 64 * (j))
#define XB_XGEN(j)  (2304 + 64 * (j))
#define XB_TOP      3328
#define XB_TOPGEN   3392
#define XCD_BAR_WORDS 3456
#define XB_SPIN_CAP (1u << 22)

__device__ __forceinline__ unsigned xb_ld(unsigned* p)              { return __hip_atomic_load(p, __ATOMIC_RELAXED, __HIP_MEMORY_SCOPE_AGENT); }
__device__ __forceinline__ unsigned xb_add(unsigned* p, unsigned v) { return __hip_atomic_fetch_add(p, v, __ATOMIC_RELAXED, __HIP_MEMORY_SCOPE_AGENT); }
__device__ __forceinline__ unsigned xb_xcc_id() { return (unsigned)__builtin_amdgcn_s_getreg((3 << 11) | 20) & 0xFu; }
#define XB_SPIN(cond, bar) do { unsigned _sp = 0; while (cond) { __builtin_amdgcn_s_sleep(1); \
    if ((++_sp & 255u) == 0u) { if (xb_ld(&(bar)[XB_TMO])) break; if (_sp > XB_SPIN_CAP) { atomicAdd(&(bar)[XB_TMO], 1u); break; } } } } while (0)

struct XcdBarrier { unsigned* bar; unsigned x; volatile LAS unsigned* st; };

__device__ __forceinline__ XcdBarrier xcd_barrier_post(unsigned* bar, volatile LAS unsigned* st) {
    XcdBarrier b; b.bar = bar; b.x = xb_xcc_id(); b.st = st;
    if (threadIdx.x == 0) (void)xb_add(&bar[XB_XCNT(b.x)], 1u);
    return b;
}
__device__ __forceinline__ void xcd_barrier_complete(unsigned* bar, unsigned x, unsigned& nloc, unsigned& nx) {
    const unsigned G = gridDim.x * gridDim.y * gridDim.z;
    unsigned sum, cnt, mine, sp = 0u;
    for (;;) {
        sum = 0u; cnt = 0u; mine = 0u;
#pragma unroll
        for (unsigned j = 0; j < 16; ++j) { const unsigned c = xb_ld(&bar[XB_XCNT(j)]); sum += c; cnt += (c > 0u) ? 1u : 0u; mine = (j == x) ? c : mine; }
        if (sum == G) break;
        __builtin_amdgcn_s_sleep(1);
        if ((++sp & 255u) == 0u) { if (xb_ld(&bar[XB_TMO])) break; if (sp > XB_SPIN_CAP) { atomicAdd(&bar[XB_TMO], 1u); break; } }
    }
    nloc = mine > 0u ? mine : 1u; nx = cnt > 0u ? cnt : 1u;
}
__device__ __forceinline__ void xcd_barrier(const XcdBarrier& b) {
    asm volatile("s_waitcnt vmcnt(0)" ::: "memory");
    __syncthreads();
    if (threadIdx.x == 0) {
        unsigned* bar = b.bar;
        __builtin_amdgcn_s_waitcnt(0);
        unsigned nloc = b.st[0], nx = b.st[1];
        if (nloc == 0u) { xcd_barrier_complete(bar, b.x, nloc, nx); b.st[0] = nloc; b.st[1] = nx; }
        const unsigned old = xb_add(&bar[XB_XSUB(b.x)], 1u);
        const unsigned gen = old / nloc;
        if (old + 1u == (gen + 1u) * nloc) {
            __builtin_amdgcn_fence(__ATOMIC_RELEASE, "agent");
            asm volatile("s_waitcnt vmcnt(0)" ::: "memory");
            const unsigned og = xb_add(&bar[XB_TOP], 1u);
            const unsigned tg = og / nx;
            if (og + 1u == (tg + 1u) * nx) xb_add(&bar[XB_TOPGEN], 1u);
            else XB_SPIN(xb_ld(&bar[XB_TOPGEN]) == tg, bar);
            __builtin_amdgcn_fence(__ATOMIC_ACQUIRE, "agent");
            xb_add(&bar[XB_XGEN(b.x)], 1u);
            asm volatile("s_waitcnt vmcnt(0)" ::: "memory");
        } else {
            XB_SPIN(xb_ld(&bar[XB_XGEN(b.x)]) == gen, bar);
            __builtin_amdgcn_fence(__ATOMIC_ACQUIRE, "agent");
            asm volatile("s_waitcnt vmcnt(0)" ::: "memory");
        }
    }
    __syncthreads();
}

namespace pg8 {
#define PG8_LAS __attribute__((address_space(3)))
constexpr int BM = 256, BK = 64, HALF = 128, HTB = HALF * BK * 2, STAGE_BYTES = 8 * HTB, NXCD = 8, WGM = 8;
__host__ __device__ __forceinline__ int lds_byte(int r, int c) { const int st = (r >> 4) * 2 + (c >> 5), rr = r & 15, cc = c & 31, ob = rr * 64 + cc * 2; return st * 1024 + (ob ^ (((ob >> 9) & 1) << 5)); }
__host__ __device__ __forceinline__ void stage_rc(int b, int& R, int& C) { const int st = b / 1024, sb = b % 1024, swz = sb ^ (((sb >> 9) & 1) << 5); R = (st >> 1) * 16 + swz / 64; C = (st & 1) * 32 + (swz % 64) / 2; }
__host__ __device__ __forceinline__ int perm32(int rho) { const int n = rho >> 4, i = rho & 15; return 8 * (i >> 2) + 4 * n + (i & 3); }
struct Unit { int pm, pn; };
struct Gemm { const bf16_t* A; const bf16_t* Bt; int M, N, K; };
struct StaticOrder {
    int nM, nN, nwg, G, c;
    __host__ __device__ void init(int M, int N, int G_, int c_) { nM = M / BM; nN = N / BM; nwg = nM * nN; G = G_; c = c_; }
    __host__ __device__ bool next(int i, Unit& u) const {
        const long L = (long)i * G + c; if (L >= nwg) return false;
        int wgid = (int)L; { const int q = nwg / NXCD, r = nwg % NXCD, xcd = wgid % NXCD, off = wgid / NXCD; wgid = (xcd < r ? xcd * (q + 1) : r * (q + 1) + (xcd - r) * q) + off; }
        const int nig = WGM * nN, gid = wgid / nig, fm = gid * WGM, gsz = (nM - fm) < WGM ? (nM - fm) : WGM;
        u.pm = fm + ((wgid % nig) % gsz); u.pn = (wgid % nig) / gsz; return true;
    }
    __device__ __forceinline__ void a_ready(const Unit&) const {}
    __device__ __forceinline__ void done(const Unit&) const {}
};
__device__ __forceinline__ unsigned cvt_pk_bf16(float lo, float hi) { unsigned r; asm volatile("v_cvt_pk_bf16_f32 %0, %1, %2" : "=v"(r) : "v"(lo), "v"(hi)); return r; }

template <class Epi, class Sched>
__device__ __forceinline__ void gemm_phase(PG8_LAS unsigned char* lds, const Gemm g, const Sched& S, const Epi& E) {
    const int tid = threadIdx.x, wid = __builtin_amdgcn_readfirstlane(tid >> 6), lane = tid & 63, wr = wid >> 2, wc = wid & 3, fr = lane & 15, fq = lane >> 4;
    const int K = g.K, nt = K / BK;
    unsigned voffA[2], voffB[2];
#pragma unroll
    for (int i = 0; i < 2; ++i) { int R, C; stage_rc(tid * 16 + i * 8192, R, C); const int Rb = Epi::PERM ? ((R & ~31) + perm32(R & 31)) : R;
        voffA[i] = (unsigned)(R * K + C) * 2u; voffB[i] = (unsigned)(Rb * K + C) * 2u; }
    const size_t kstep = (size_t)(BK * 2);
    const size_t hstep = (size_t)HALF * K * 2;
    const size_t tstep = 2 * hstep;
    const unsigned ldsw = (unsigned)wid * 1024u;
    const int aoff = lds_byte(wr * 64 + fr, fq * 8), boff = lds_byte(wc * 32 + fr, fq * 8);
#define PG8_SA(b, h) (((b) * 2 + (h)) * HTB)
#define PG8_SB(b, h) ((4 + (b) * 2 + (h)) * HTB)
#define PG8_STAGE(bufoff, gbase, voff) do { _Pragma("unroll") for (int _i = 0; _i < 2; ++_i) \
        __builtin_amdgcn_global_load_lds((const unsigned*)((const char*)(gbase) + (voff)[_i]), (PG8_LAS unsigned*)(lds + (bufoff) + ldsw + _i * 8192), 16, 0, 0); } while (0)
#define PG8_LDA(dst, b, h) do { _Pragma("unroll") for (int m = 0; m < 4; ++m) _Pragma("unroll") for (int k = 0; k < 2; ++k) dst[m][k] = *(const PG8_LAS bf16x8*)(lds + PG8_SA(b, h) + aoff + m * 2048 + k * 1024); } while (0)
#define PG8_LDB(dst, b, h) do { _Pragma("unroll") for (int n = 0; n < 2; ++n) _Pragma("unroll") for (int k = 0; k < 2; ++k) dst[n][k] = *(const PG8_LAS bf16x8*)(lds + PG8_SB(b, h) + boff + n * 2048 + k * 1024); } while (0)
#define PG8_MMA(ai, bj, At, Bt) do { __builtin_amdgcn_s_setprio(1); _Pragma("unroll") for (int m = 0; m < 4; ++m) _Pragma("unroll") for (int n = 0; n < 2; ++n) _Pragma("unroll") for (int k = 0; k < 2; ++k) \
        acc[ai][bj][m][n] = __builtin_amdgcn_mfma_f32_16x16x32_bf16(Bt[n][k], At[m][k], acc[ai][bj][m][n], 0, 0, 0); __builtin_amdgcn_s_setprio(0); } while (0)
#define PG8_WAIT_V(n) asm volatile("s_waitcnt vmcnt(" #n ")" ::: "memory")
#define PG8_WAIT_L(n) asm volatile("s_waitcnt lgkmcnt(" #n ")" ::: "memory")
#define PG8_BAR __builtin_amdgcn_s_barrier()
#define PG8_SCHED __builtin_amdgcn_sched_barrier(0)
    Unit cur, nxt; int ui = 0;
    if (!S.next(0, cur)) return;
    f32x4 acc[2][2][4][2];
#pragma unroll
    for (int a = 0; a < 2; ++a)
#pragma unroll
        for (int b = 0; b < 2; ++b)
#pragma unroll
            for (int m = 0; m < 4; ++m)
#pragma unroll
                for (int n = 0; n < 2; ++n) acc[a][b][m][n] = (f32x4){0.f, 0.f, 0.f, 0.f};
    bf16x8 At[4][2], B0[2][2], B1[2][2];
    const char* cA = (const char*)g.A + (size_t)cur.pm * tstep; const char* cB = (const char*)g.Bt + (size_t)cur.pn * tstep;
    S.a_ready(cur);
    PG8_STAGE(PG8_SB(0, 0), cB, voffB); PG8_STAGE(PG8_SA(0, 0), cA, voffA); PG8_STAGE(PG8_SB(0, 1), cB + hstep, voffB); PG8_STAGE(PG8_SA(0, 1), cA + hstep, voffA);
    if (wr == 1) PG8_BAR;
    PG8_WAIT_V(4); PG8_BAR;
    PG8_STAGE(PG8_SB(1, 0), cB + kstep, voffB); PG8_STAGE(PG8_SA(1, 0), cA + kstep, voffA); PG8_STAGE(PG8_SB(1, 1), cB + hstep + kstep, voffB);
    PG8_WAIT_V(6); PG8_BAR;
    for (;;) {
        const bool has_next = S.next(ui + 1, nxt);
        const char* nA = has_next ? (const char*)g.A + (size_t)nxt.pm * tstep : cA; const char* nB = has_next ? (const char*)g.Bt + (size_t)nxt.pn * tstep : cB;
        for (int t = 0; t < nt; t += 2) {
            const bool last = (t == nt - 2);
            const char* a1 = cA + (size_t)(t + 1) * kstep;
            const char* a2 = last ? nA : cA + (size_t)(t + 2) * kstep; const char* b2 = last ? nB : cB + (size_t)(t + 2) * kstep;
            const char* a3 = a2 + kstep; const char* b3 = b2 + kstep;
            if (last && has_next) S.a_ready(nxt);
            PG8_LDB(B0, 0, 0); PG8_SCHED; PG8_LDA(At, 0, 0); PG8_STAGE(PG8_SA(1, 1), a1 + hstep, voffA);
            PG8_WAIT_L(8); PG8_BAR; PG8_WAIT_L(0); PG8_MMA(0, 0, At, B0); PG8_BAR; PG8_SCHED;
            PG8_LDB(B1, 0, 1); PG8_STAGE(PG8_SB(0, 0), b2, voffB);
            PG8_BAR; PG8_WAIT_L(0); PG8_MMA(0, 1, At, B1); PG8_BAR;
            PG8_LDA(At, 0, 1); PG8_STAGE(PG8_SA(0, 0), a2, voffA);
            PG8_BAR; PG8_WAIT_L(0); PG8_MMA(1, 0, At, B0); PG8_BAR; PG8_SCHED;
            PG8_STAGE(PG8_SB(0, 1), b2 + hstep, voffB);
            PG8_WAIT_V(6); PG8_BAR; PG8_MMA(1, 1, At, B1); PG8_BAR;
            PG8_LDB(B0, 1, 0); PG8_SCHED; PG8_LDA(At, 1, 0); PG8_STAGE(PG8_SA(0, 1), a2 + hstep, voffA);
            PG8_WAIT_L(8); PG8_BAR; PG8_WAIT_L(0); PG8_MMA(0, 0, At, B0); PG8_BAR; PG8_SCHED;
            PG8_LDB(B1, 1, 1); PG8_STAGE(PG8_SB(1, 0), b3, voffB);
            PG8_BAR; PG8_WAIT_L(0); PG8_MMA(0, 1, At, B1); PG8_BAR;
            PG8_LDA(At, 1, 1); PG8_STAGE(PG8_SA(1, 0), a3, voffA);
            PG8_BAR; PG8_WAIT_L(0); PG8_MMA(1, 0, At, B0); PG8_BAR; PG8_SCHED;
            PG8_STAGE(PG8_SB(1, 1), b3 + hstep, voffB);
            PG8_WAIT_V(6); PG8_BAR; PG8_MMA(1, 1, At, B1); PG8_BAR;
        }
        E(acc, cur, wr, wc, fr, fq); S.done(cur);
        if (!has_next) break;
#pragma unroll
        for (int a = 0; a < 2; ++a)
#pragma unroll
            for (int b = 0; b < 2; ++b)
#pragma unroll
                for (int m = 0; m < 4; ++m)
#pragma unroll
                    for (int n = 0; n < 2; ++n) acc[a][b][m][n] = (f32x4){0.f, 0.f, 0.f, 0.f};
        cur = nxt; cA = nA; cB = nB; ++ui;
    }
    PG8_WAIT_V(0);
    if (wr == 0) PG8_BAR;
    PG8_BAR;
#undef PG8_SA
#undef PG8_SB
#undef PG8_STAGE
#undef PG8_LDA
#undef PG8_LDB
#undef PG8_MMA
#undef PG8_WAIT_V
#undef PG8_WAIT_L
#undef PG8_BAR
#undef PG8_SCHED
}
}

struct Params {
    const float *x, *w_in, *ret_nw, *hg_nw, *lb_logits, *w_out, *nmix_w, *nmoe_w, *w_router, *b_router, *w1, *b1, *w2, *b2, *nfin_w;
    float* out;
    bf16_t *w_in_t, *w_out_t, *w1t, *w2t, *hn, *z, *merged, *hn2, *xg, *hid, *y;
    float *o_r, *o_h, *h2, *cosT, *sinT, *b1p, *tk_g, *row_gate;
    int *gcnt, *tk_e, *tk_rank, *pos, *whist;
    float* diag;
    unsigned* bar;
    long long lo_hi;
};

__device__ __forceinline__ float bf2f(unsigned short b) { return __uint_as_float(((unsigned)b) << 16); }
typedef __bf16 bf16v2_t __attribute__((ext_vector_type(2)));
typedef float f32x2_t __attribute__((ext_vector_type(2)));
__device__ __forceinline__ unsigned cvt2(float lo, float hi) { const bf16v2_t r = __builtin_convertvector((f32x2_t){lo, hi}, bf16v2_t); return __builtin_bit_cast(unsigned, r); }
__device__ __forceinline__ unsigned short f2bf(float f) { return (unsigned short)(cvt2(f, 0.f) & 0xffffu); }
__device__ __forceinline__ float wave_sum(float v) {
#pragma unroll
    for (int o = 32; o >= 1; o >>= 1) v += __shfl_xor(v, o);
    return v;
}
__device__ __forceinline__ float sigmoidf_(float x) { return 1.0f / (1.0f + __expf(-x)); }
__device__ __forceinline__ f32x4 mma16(bf16x8 a, bf16x8 b, f32x4 c) { return __builtin_amdgcn_mfma_f32_16x16x32_bf16(a, b, c, 0, 0, 0); }
__device__ __forceinline__ bf16x8 ldfrag(const LAS bf16_t* base, int ld, int r0, int k0, int lane) {
    return *(const LAS bf16x8*)(base + (r0 + (lane & 15)) * ld + k0 + (lane >> 4) * 8);
}

template <int MODE>
__device__ __forceinline__ void tr_tile(const float* src, int ldsrc, bf16_t* dst, int lddst, int k0, int c0, LAS float* tl) {
    const int t = threadIdx.x;
    {
        const int c = t & 63, r0 = t >> 6;
#pragma unroll
        for (int i = 0; i < 8; ++i) tl[(r0 + 8 * i) * 65 + c] = src[(size_t)(k0 + r0 + 8 * i) * ldsrc + c0 + c];
    }
    __syncthreads();
    {
        const int cl = t >> 3, ko = (t & 7) * 8;
        float v[8];
#pragma unroll
        for (int j = 0; j < 8; ++j) v[j] = tl[(ko + j) * 65 + cl];
        const int col = c0 + cl;
        int drow = col;
        if (MODE == 1) { const int j = col >> 1, lin = col & 1; drow = (j >> 7) * 256 + lin * 128 + (j & 127); }
        u32x4 w; w.x = cvt2(v[0], v[1]); w.y = cvt2(v[2], v[3]); w.z = cvt2(v[4], v[5]); w.w = cvt2(v[6], v[7]);
        *(u32x4*)(dst + (size_t)drow * lddst + k0 + ko) = w;
    }
    __syncthreads();
}

__device__ __forceinline__ void rms_rows_to_bf16(const float* src, const float* w, bf16_t* dst, int bid, int nb) {
    const int lane = threadIdx.x & 63, wid = threadIdx.x >> 6;
    for (int row = bid * 8 + wid; row < NT; row += nb * 8) {
        const f32x4* xr = (const f32x4*)(src + (size_t)row * DM);
        f32x4 v[8]; float ss = 0.f;
#pragma unroll
        for (int i = 0; i < 8; ++i) { v[i] = xr[i * 64 + lane]; ss += v[i][0] * v[i][0] + v[i][1] * v[i][1] + v[i][2] * v[i][2] + v[i][3] * v[i][3]; }
        ss = wave_sum(ss);
        const float rstd = rsqrtf(ss * (1.0f / DM) + 1e-6f);
#pragma unroll
        for (int i = 0; i < 8; ++i) {
            const f32x4 wv = ((const f32x4*)w)[i * 64 + lane];
            u32x2 o; o.x = cvt2(v[i][0] * rstd * wv[0], v[i][1] * rstd * wv[1]); o.y = cvt2(v[i][2] * rstd * wv[2], v[i][3] * rstd * wv[3]);
            *(u32x2*)(dst + (size_t)row * DM + (i * 64 + lane) * 4) = o;
        }
    }
}

__device__ __forceinline__ void p0_prologue(const Params& p, LAS unsigned char* lds, int bid, int nb) {
    LAS float* tl = (LAS float*)lds;
    const int tid = threadIdx.x;
    for (int i = bid * NTHREADS + tid; i < SEQ * 128; i += nb * NTHREADS) {
        const int s = i >> 7, pr = i & 127;
        const float inv = exp2f(-(float)pr * (13.287712379549449f / 127.0f));
        const double rev = (double)s * (double)inv * 0.15915494309189535;
        const float fr = (float)(rev - floor(rev));
        p.cosT[i] = __builtin_amdgcn_cosf(fr); p.sinT[i] = __builtin_amdgcn_sinf(fr);
    }
    for (int i = bid * NTHREADS + tid; i < NE * 4096; i += nb * NTHREADS) {
        const int e = i >> 12, np = i & 4095, pn = np >> 8, cl = np & 255, j = pn * 128 + (cl & 127);
        p.b1p[i] = p.b1[e * 4096 + 2 * j + (cl >> 7)];
    }
    rms_rows_to_bf16(p.x, p.nmix_w, p.hn, bid, nb);
    for (int t = bid; t < 32 * 320; t += nb) { const int kt = t / 320, ct = t % 320; tr_tile<0>(p.w_in, NZ, p.w_in_t, DM, kt * 64, ct * 64, tl); }
    for (int t = bid; t < 32 * 32; t += nb) { const int kt = t >> 5, ct = t & 31; tr_tile<0>(p.w_out, DM, p.w_out_t, DM, kt * 64, ct * 64, tl); }
    for (int t = bid; t < NE * 32 * 64; t += nb) { const int e = t >> 11, r = t & 2047, kt = r >> 6, ct = r & 63;
        tr_tile<1>(p.w1 + (size_t)e * DM * 4096, 4096, p.w1t + (size_t)e * 4096 * DM, DM, kt * 64, ct * 64, tl); }
    for (int t = bid; t < NE * 32 * 32; t += nb) { const int e = t >> 10, r = t & 1023, kt = r >> 5, ct = r & 31;
        tr_tile<0>(p.w2 + (size_t)e * DFF * DM, DM, p.w2t + (size_t)e * DM * DFF, DFF, kt * 64, ct * 64, tl); }
}

struct EpiZ {
    static constexpr bool PERM = true, AFTER_DRAIN = false;
    bf16_t* Z; const float* cosT; const float* sinT;
    __device__ __forceinline__ void operator()(const f32x4 (&acc)[2][2][4][2], const pg8::Unit& u, int wr, int wc, int fr, int fq) const {
        const int row0 = u.pm * 256 + wr * 64 + fr, pc = wc * 32 + 8 * fq, col0 = u.pn * 256 + pc;
        const bool rot = u.pn < 16; const float sc = (u.pn >= 8 && u.pn < 16) ? 0.0625f : 1.0f;
#pragma unroll
        for (int ai = 0; ai < 2; ++ai)
#pragma unroll
            for (int m = 0; m < 4; ++m) {
                const int row = row0 + ai * 128 + m * 16;
                f32x4 a0 = acc[ai][0][m][0], a1 = acc[ai][0][m][1], b0 = acc[ai][1][m][0], b1 = acc[ai][1][m][1];
                if (rot) {
                    const int s = row & (SEQ - 1);
                    const f32x4 c0 = *(const f32x4*)(cosT + s * 128 + pc), c1 = *(const f32x4*)(cosT + s * 128 + pc + 4);
                    const f32x4 s0 = *(const f32x4*)(sinT + s * 128 + pc), s1 = *(const f32x4*)(sinT + s * 128 + pc + 4);
                    const f32x4 na0 = (a0 * c0 - b0 * s0) * sc, na1 = (a1 * c1 - b1 * s1) * sc;
                    const f32x4 nb0 = (b0 * c0 + a0 * s0) * sc, nb1 = (b1 * c1 + a1 * s1) * sc;
                    a0 = na0; a1 = na1; b0 = nb0; b1 = nb1;
                }
                bf16_t* rowp = Z + (size_t)row * NZ + col0;
                u32x4 w; w.x = cvt2(a0[0], a0[1]); w.y = cvt2(a0[2], a0[3]); w.z = cvt2(a1[0], a1[1]); w.w = cvt2(a1[2], a1[3]);
                *(u32x4*)(rowp) = w;
                u32x4 v; v.x = cvt2(b0[0], b0[1]); v.y = cvt2(b0[2], b0[3]); v.z = cvt2(b1[0], b1[1]); v.w = cvt2(b1[2], b1[3]);
                *(u32x4*)(rowp + 128) = v;
            }
    }
};
struct EpiRes {
    static constexpr bool PERM = false, AFTER_DRAIN = false;
    float* C; const float* R;
    __device__ __forceinline__ void operator()(const f32x4 (&acc)[2][2][4][2], const pg8::Unit& u, int wr, int wc, int fr, int fq) const {
        const int row0 = u.pm * 256 + wr * 64 + fr, col0 = u.pn * 256 + wc * 32 + 4 * fq;
#pragma unroll
        for (int ai = 0; ai < 2; ++ai)
#pragma unroll
            for (int m = 0; m < 4; ++m) {
                const size_t ro = (size_t)(row0 + ai * 128 + m * 16) * DM + col0;
#pragma unroll
                for (int bj = 0; bj < 2; ++bj)
#pragma unroll
                    for (int n = 0; n < 2; ++n) { const f32x4 r = *(const f32x4*)(R + ro + bj * 128 + n * 16); *(f32x4*)(C + ro + bj * 128 + n * 16) = acc[ai][bj][m][n] + r; }
            }
    }
};
struct EpiSwiglu {
    static constexpr bool PERM = true, AFTER_DRAIN = false;
    bf16_t* H; const float* b1p;
    __device__ __forceinline__ void operator()(const f32x4 (&acc)[2][2][4][2], const pg8::Unit& u, int wr, int wc, int fr, int fq) const {
        const int e = u.pn >> 4, pnl = u.pn & 15, pc = wc * 32 + 8 * fq;
        const float* bp = b1p + e * 4096 + pnl * 256 + pc;
        const f32x4 bg0 = *(const f32x4*)(bp), bg1 = *(const f32x4*)(bp + 4), bl0 = *(const f32x4*)(bp + 128), bl1 = *(const f32x4*)(bp + 132);
        const int row0 = u.pm * 256 + wr * 64 + fr;
#pragma unroll
        for (int ai = 0; ai < 2; ++ai)
#pragma unroll
            for (int m = 0; m < 4; ++m) {
                const int row = row0 + ai * 128 + m * 16;
                const f32x4 g0 = acc[ai][0][m][0] + bg0, g1 = acc[ai][0][m][1] + bg1, l0 = acc[ai][1][m][0] + bl0, l1 = acc[ai][1][m][1] + bl1;
                float o[8];
#pragma unroll
                for (int i = 0; i < 4; ++i) {
                    { const float xg = fminf(g0[i], 7.0f), xl = fminf(fmaxf(l0[i], -7.0f), 7.0f); o[i] = xg * sigmoidf_(1.702f * xg) * (xl + 1.0f); }
                    { const float xg = fminf(g1[i], 7.0f), xl = fminf(fmaxf(l1[i], -7.0f), 7.0f); o[4 + i] = xg * sigmoidf_(1.702f * xg) * (xl + 1.0f); }
                }
                u32x4 w; w.x = cvt2(o[0], o[1]); w.y = cvt2(o[2], o[3]); w.z = cvt2(o[4], o[5]); w.w = cvt2(o[6], o[7]);
                *(u32x4*)(H + (size_t)row * DFF + pnl * 128 + pc) = w;
            }
    }
};
struct EpiY {
    static constexpr bool PERM = true, AFTER_DRAIN = false;
    bf16_t* Y; const float* b2; const float* gate;
    __device__ __forceinline__ void operator()(const f32x4 (&acc)[2][2][4][2], const pg8::Unit& u, int wr, int wc, int fr, int fq) const {
        const int e = u.pn >> 3, pnl = u.pn & 7, col0 = pnl * 256 + wc * 32 + 8 * fq;
        const float* bp = b2 + e * DM + col0;
        f32x4 bv[2][2];
#pragma unroll
        for (int bj = 0; bj < 2; ++bj)
#pragma unroll
            for (int n = 0; n < 2; ++n) bv[bj][n] = *(const f32x4*)(bp + bj * 128 + 4 * n);
        const int row0 = u.pm * 256 + wr * 64 + fr;
#pragma unroll
        for (int ai = 0; ai < 2; ++ai)
#pragma unroll
            for (int m = 0; m < 4; ++m) {
                const int row = row0 + ai * 128 + m * 16;
                const float gt = gate[row];
#pragma unroll
                for (int bj = 0; bj < 2; ++bj) {
                    const f32x4 v0 = (acc[ai][bj][m][0] + bv[bj][0]) * gt, v1 = (acc[ai][bj][m][1] + bv[bj][1]) * gt;
                    u32x4 w; w.x = cvt2(v0[0], v0[1]); w.y = cvt2(v0[2], v0[3]); w.z = cvt2(v1[0], v1[1]); w.w = cvt2(v1[2], v1[3]);
                    *(u32x4*)(Y + (size_t)row * DM + col0 + bj * 128) = w;
                }
            }
    }
};

struct MoeOrder {
    int nM, nN, nwg, G, c; const LAS int* tile_e;
    __device__ void init(int nM_, int nN_, int G_, int c_, const LAS int* te) { nM = nM_; nN = nN_; nwg = nM * nN; G = G_; c = c_; tile_e = te; }
    __device__ bool next(int i, pg8::Unit& u) const {
        const long L = (long)i * G + c; if (L >= nwg) return false;
        int wgid = (int)L; { const int q = nwg / pg8::NXCD, r = nwg % pg8::NXCD, xcd = wgid % pg8::NXCD, off = wgid / pg8::NXCD; wgid = (xcd < r ? xcd * (q + 1) : r * (q + 1) + (xcd - r) * q) + off; }
        const int nig = pg8::WGM * nN, gid = wgid / nig, fm = gid * pg8::WGM, gsz = (nM - fm) < pg8::WGM ? (nM - fm) : pg8::WGM;
        u.pm = fm + ((wgid % nig) % gsz); const int pnl = (wgid % nig) / gsz; u.pn = tile_e[u.pm] * nN + pnl; return true;
    }
    __device__ __forceinline__ void a_ready(const pg8::Unit&) const {}
    __device__ __forceinline__ void done(const pg8::Unit&) const {}
};

__device__ __forceinline__ void build_tiles(const Params& p, LAS int* tb) {
    if (threadIdx.x == 0) {
        int t = 0;
        for (int e = 0; e < NE; ++e) {
            const int c = p.gcnt[e], nt = (c + 255) >> 8;
            tb[1 + e] = t * 256;
            for (int k = 0; k < nt; ++k) tb[64 + t + k] = e;
            t += nt;
        }
        tb[0] = t;
    }
    __syncthreads();
}

__device__ __forceinline__ void mixer_ret(const Params& p, LAS unsigned char* lds, int unit) {
    const int tid = threadIdx.x, lane = tid & 63, wid = tid >> 6, quad = lane >> 4, l15 = lane & 15;
    const int sl = unit & 7, h = (unit >> 3) & 7, b = unit >> 6;
    LAS bf16_t* Qs = (LAS bf16_t*)lds;
    LAS bf16_t* Ks = Qs + 64 * 264;
    LAS bf16_t* KsT = Ks + 64 * 264;
    LAS bf16_t* Vt = KsT + 256 * 72;
    LAS bf16_t* Vz = Vt + 32 * 72;
    LAS bf16_t* Ps = Vz + 32 * 72;
    LAS bf16_t* St = Ps + 64 * 72;
    const float lg2 = log2f(1.0f - exp2f(-5.0f - (float)h));
    const float g64 = exp2f(64.0f * lg2);
    for (int i = tid; i < 32 * 264 / 2; i += NTHREADS) ((LAS unsigned*)St)[i] = 0u;
    f32x4 Sacc[2][2];
#pragma unroll
    for (int a = 0; a < 2; ++a)
#pragma unroll
        for (int c = 0; c < 2; ++c) Sacc[a][c] = (f32x4){0.f, 0.f, 0.f, 0.f};
    const bf16_t* zb = p.z + (size_t)(b * SEQ) * NZ;
    const int qcol = h * 256, kcol = 2048 + h * 256, vcol = 4096 + h * 256 + sl * 32;
    u32x4 rq[4], rk[4], rv = (u32x4){0u, 0u, 0u, 0u};
#define RET_ISSUE(n) do { _Pragma("unroll") for (int i = 0; i < 4; ++i) { const int piece = tid + NTHREADS * i, row = piece >> 5, cc = (piece & 31) * 8; \
            const bf16_t* rp = zb + (size_t)((n) * 64 + row) * NZ; rq[i] = *(const u32x4*)(rp + qcol + cc); rk[i] = *(const u32x4*)(rp + kcol + cc); } \
        if (tid < 256) { const int row = tid >> 2, cc = (tid & 3) * 8; rv = *(const u32x4*)(zb + (size_t)((n) * 64 + row) * NZ + vcol + cc); } } while (0)
    RET_ISSUE(0);
    for (int n = 0; n < 64; ++n) {
#pragma unroll
        for (int i = 0; i < 4; ++i) {
            const int piece = tid + NTHREADS * i, row = piece >> 5, cc = (piece & 31) * 8;
            *(LAS u32x4*)(Qs + row * 264 + cc) = rq[i];
            *(LAS u32x4*)(Ks + row * 264 + cc) = rk[i];
#pragma unroll
            for (int j = 0; j < 4; ++j) { const unsigned wv = rk[i][j]; KsT[(cc + 2 * j) * 72 + row] = (bf16_t)(wv & 0xffffu); KsT[(cc + 2 * j + 1) * 72 + row] = (bf16_t)(wv >> 16); }
        }
        if (tid < 256) {
            const int row = tid >> 2, cc = (tid & 3) * 8;
            const float zeta = exp2f((float)(63 - row) * lg2);
#pragma unroll
            for (int j = 0; j < 4; ++j) {
                const unsigned wv = rv[j]; const bf16_t lo = (bf16_t)(wv & 0xffffu), hi = (bf16_t)(wv >> 16);
                Vt[(cc + 2 * j) * 72 + row] = lo; Vt[(cc + 2 * j + 1) * 72 + row] = hi;
                Vz[(cc + 2 * j) * 72 + row] = f2bf(bf2f(lo) * zeta); Vz[(cc + 2 * j + 1) * 72 + row] = f2bf(bf2f(hi) * zeta);
            }
        }
        if (n + 1 < 64) RET_ISSUE(n + 1);
        __syncthreads();
        {
            const int mi = wid >> 1, nb0 = (wid & 1) * 2;
            f32x4 a0 = (f32x4){0.f, 0.f, 0.f, 0.f}, a1 = a0;
#pragma unroll
            for (int ks = 0; ks < 8; ++ks) {
                const bf16x8 A = ldfrag(Qs, 264, mi * 16, ks * 32, lane);
                const bf16x8 B0 = ldfrag(Ks, 264, nb0 * 16, ks * 32, lane), B1 = ldfrag(Ks, 264, nb0 * 16 + 16, ks * 32, lane);
                a0 = mma16(A, B0, a0); a1 = mma16(A, B1, a1);
            }
#pragma unroll
            for (int jj = 0; jj < 4; ++jj) {
                const int i = mi * 16 + quad * 4 + jj, j0 = nb0 * 16 + l15, j1 = j0 + 16;
                Ps[i * 72 + j0] = f2bf(a0[jj] * exp2f(fabsf((float)(i - j0)) * lg2));
                Ps[i * 72 + j1] = f2bf(a1[jj] * exp2f(fabsf((float)(i - j1)) * lg2));
            }
        }
        __syncthreads();
        {
            const int mi = wid >> 1, ni = wid & 1;
            f32x4 a1 = (f32x4){0.f, 0.f, 0.f, 0.f}, a2 = a1;
#pragma unroll
            for (int ks = 0; ks < 2; ++ks) a1 = mma16(ldfrag(Ps, 72, mi * 16, ks * 32, lane), ldfrag(Vt, 72, ni * 16, ks * 32, lane), a1);
#pragma unroll
            for (int ks = 0; ks < 8; ++ks) a2 = mma16(ldfrag(Qs, 264, mi * 16, ks * 32, lane), ldfrag(St, 264, ni * 16, ks * 32, lane), a2);
#pragma unroll
            for (int jj = 0; jj < 4; ++jj) {
                const int i = mi * 16 + quad * 4 + jj;
                const float xi = exp2f((float)(i + 1) * lg2);
                p.o_r[(size_t)(b * SEQ + n * 64 + i) * DM + h * 256 + sl * 32 + ni * 16 + l15] = a1[jj] + xi * a2[jj];
            }
        }
        __syncthreads();
        {
#pragma unroll
            for (int mt = 0; mt < 2; ++mt) {
                const int mi = wid * 2 + mt;
#pragma unroll
                for (int ni = 0; ni < 2; ++ni) {
                    f32x4 s = Sacc[mt][ni] * g64;
#pragma unroll
                    for (int ks = 0; ks < 2; ++ks) s = mma16(ldfrag(KsT, 72, mi * 16, ks * 32, lane), ldfrag(Vz, 72, ni * 16, ks * 32, lane), s);
                    Sacc[mt][ni] = s;
                    u32x2 w; w.x = cvt2(s[0], s[1]); w.y = cvt2(s[2], s[3]);
                    *(LAS u32x2*)(St + (ni * 16 + l15) * 264 + mi * 16 + quad * 4) = w;
                }
            }
        }
        __syncthreads();
    }
#undef RET_ISSUE
}

__device__ __forceinline__ void mixer_hg(const Params& p, LAS unsigned char* lds, int unit) {
    const int tid = threadIdx.x, lane = tid & 63, wid = tid >> 6, quad = lane >> 4, l15 = lane & 15;
    const int sl = unit & 3, h = (unit >> 2) & 15, b = unit >> 6;
    LAS bf16_t* As = (LAS bf16_t*)lds;
    LAS bf16_t* Bs = As + 64 * 136;
    LAS bf16_t* K2t = Bs + 64 * 136;
    LAS bf16_t* Vt = K2t + 128 * 72;
    LAS bf16_t* Ps = Vt + 32 * 72;
    LAS bf16_t* St = Ps + 64 * 72;
    LAS float* e63 = (LAS float*)(St + 32 * 136);
    LAS float* cpart = e63 + 128;
    const int d = tid & 127, g = tid >> 7;
    const float lbv = 1.0f / (1.0f + __expf(p.lb_logits[DM + h * 128 + d] - p.lb_logits[h * 128 + d]));
    const float om = 1.0f - lbv;
    for (int i = tid; i < 32 * 136 / 2; i += NTHREADS) ((LAS unsigned*)St)[i] = 0u;
    f32x4 Sacc[2];
    Sacc[0] = (f32x4){0.f, 0.f, 0.f, 0.f}; Sacc[1] = Sacc[0];
    const bf16_t* zb = p.z + (size_t)(b * SEQ) * NZ;
    const int qcol = 8192 + h * 128 + d, fcol = 10240 + h * 128 + d, vcol = 12288 + h * 128 + sl * 32;
    unsigned short rqh[16], rfh[16]; u32x4 rv = (u32x4){0u, 0u, 0u, 0u};
#define HG_ISSUE(n) do { _Pragma("unroll") for (int r = 0; r < 16; ++r) { const bf16_t* rp = zb + (size_t)((n) * 64 + 16 * g + r) * NZ; rqh[r] = rp[qcol]; rfh[r] = rp[fcol]; } \
        if (tid < 256) { const int row = tid >> 2, cc = (tid & 3) * 8; rv = *(const u32x4*)(zb + (size_t)((n) * 64 + row) * NZ + vcol + cc); } } while (0)
    HG_ISSUE(0);
    for (int n = 0; n < 64; ++n) {
        float cl[16], kk[16]; float c = 0.f;
#pragma unroll
        for (int r = 0; r < 16; ++r) { const float sg = sigmoidf_(bf2f(rfh[r])); const float f = lbv + om * sg; c += __logf(f); cl[r] = c; kk[r] = om * (1.0f - sg); }
        cpart[g * 128 + d] = c;
        if (tid < 256) {
            const int row = tid >> 2, cc = (tid & 3) * 8;
#pragma unroll
            for (int j = 0; j < 4; ++j) { const unsigned wv = rv[j]; Vt[(cc + 2 * j) * 72 + row] = (bf16_t)(wv & 0xffffu); Vt[(cc + 2 * j + 1) * 72 + row] = (bf16_t)(wv >> 16); }
        }
        __syncthreads();
        {
            float off = 0.f, tot = 0.f;
#pragma unroll
            for (int gg = 0; gg < 4; ++gg) { const float v = cpart[gg * 128 + d]; tot += v; off += (gg < g) ? v : 0.f; }
            unsigned k2p[8];
#pragma unroll
            for (int r = 0; r < 16; r += 2) {
                float k2v[2];
#pragma unroll
                for (int q = 0; q < 2; ++q) {
                    const float cum = off + cl[r + q]; const float qv = bf2f(rqh[r + q]);
                    const float a = qv * sigmoidf_(qv) * __expf(cum), bv = kk[r + q] * __expf(-cum);
                    k2v[q] = kk[r + q] * __expf(tot - cum);
                    As[(16 * g + r + q) * 136 + d] = f2bf(a); Bs[(16 * g + r + q) * 136 + d] = f2bf(bv);
                }
                k2p[r >> 1] = cvt2(k2v[0], k2v[1]);
            }
            *(LAS u32x4*)(K2t + d * 72 + 16 * g) = (u32x4){k2p[0], k2p[1], k2p[2], k2p[3]};
            *(LAS u32x4*)(K2t + d * 72 + 16 * g + 8) = (u32x4){k2p[4], k2p[5], k2p[6], k2p[7]};
            if (g == 0) e63[d] = __expf(tot);
        }
        if (n + 1 < 64) HG_ISSUE(n + 1);
        __syncthreads();
        {
            const int mi = wid >> 1, nb0 = (wid & 1) * 2;
            f32x4 a0 = (f32x4){0.f, 0.f, 0.f, 0.f}, a1 = a0;
#pragma unroll
            for (int ks = 0; ks < 4; ++ks) {
                const bf16x8 A = ldfrag(As, 136, mi * 16, ks * 32, lane);
                a0 = mma16(A, ldfrag(Bs, 136, nb0 * 16, ks * 32, lane), a0); a1 = mma16(A, ldfrag(Bs, 136, nb0 * 16 + 16, ks * 32, lane), a1);
            }
#pragma unroll
            for (int jj = 0; jj < 4; ++jj) {
                const int i = mi * 16 + quad * 4 + jj, j0 = nb0 * 16 + l15, j1 = j0 + 16;
                Ps[i * 72 + j0] = (i >= j0) ? f2bf(a0[jj]) : (bf16_t)0; Ps[i * 72 + j1] = (i >= j1) ? f2bf(a1[jj]) : (bf16_t)0;
            }
        }
        __syncthreads();
        {
            const int mi = wid >> 1, ni = wid & 1;
            f32x4 a = (f32x4){0.f, 0.f, 0.f, 0.f};
#pragma unroll
            for (int ks = 0; ks < 2; ++ks) a = mma16(ldfrag(Ps, 72, mi * 16, ks * 32, lane), ldfrag(Vt, 72, ni * 16, ks * 32, lane), a);
#pragma unroll
            for (int ks = 0; ks < 4; ++ks) a = mma16(ldfrag(As, 136, mi * 16, ks * 32, lane), ldfrag(St, 136, ni * 16, ks * 32, lane), a);
#pragma unroll
            for (int jj = 0; jj < 4; ++jj) {
                const int i = mi * 16 + quad * 4 + jj;
                p.o_h[(size_t)(b * SEQ + n * 64 + i) * DM + h * 128 + sl * 32 + ni * 16 + l15] = a[jj];
            }
        }
        __syncthreads();
        {
            const int mi = wid;
            const f32x4 ev = *(const LAS f32x4*)(e63 + mi * 16 + quad * 4);
#pragma unroll
            for (int ni = 0; ni < 2; ++ni) {
                f32x4 s = Sacc[ni] * ev;
#pragma unroll
                for (int ks = 0; ks < 2; ++ks) s = mma16(ldfrag(K2t, 72, mi * 16, ks * 32, lane), ldfrag(Vt, 72, ni * 16, ks * 32, lane), s);
                Sacc[ni] = s;
                u32x2 w; w.x = cvt2(s[0], s[1]); w.y = cvt2(s[2], s[3]);
                *(LAS u32x2*)(St + (ni * 16 + l15) * 136 + mi * 16 + quad * 4) = w;
            }
        }
        __syncthreads();
    }
#undef HG_ISSUE
}

__device__ __forceinline__ void p3_merge(const Params& p, int bid, int nb) {
    const int t = threadIdx.x, c = 4 * t;
    const f32x4 wr4 = *(const f32x4*)(p.ret_nw + c), wh4 = *(const f32x4*)(p.hg_nw + c);
    for (int row = bid; row < NT; row += nb) {
        const f32x4 orv = *(const f32x4*)(p.o_r + (size_t)row * DM + c), ohv = *(const f32x4*)(p.o_h + (size_t)row * DM + c);
        const bf16_t* zr = p.z + (size_t)row * NZ;
        const u32x2 rg = *(const u32x2*)(zr + 6144 + c), hg = *(const u32x2*)(zr + 14336 + c), gr = *(const u32x2*)(zr + 16384 + c), gh = *(const u32x2*)(zr + 18432 + c);
        float s = (orv[0] + orv[1]) + (orv[2] + orv[3]);
        s = wave_sum(s);
        const float mean = s * (1.0f / 256.0f);
        const f32x4 dv = orv - mean;
        float q = (dv[0] * dv[0] + dv[1] * dv[1]) + (dv[2] * dv[2] + dv[3] * dv[3]);
        q = wave_sum(q);
        const float rs = rsqrtf(q * (1.0f / 256.0f) + 1e-6f);
        float q2 = (ohv[0] * ohv[0] + ohv[1] * ohv[1]) + (ohv[2] * ohv[2] + ohv[3] * ohv[3]);
#pragma unroll
        for (int o = 16; o >= 1; o >>= 1) q2 += __shfl_xor(q2, o);
        const float rs2 = rsqrtf(q2 * (1.0f / 128.0f) + 1e-6f);
        float o4[4];
#pragma unroll
        for (int i = 0; i < 4; ++i) {
            const unsigned rgw = (i < 2) ? rg.x : rg.y, hgw = (i < 2) ? hg.x : hg.y, grw = (i < 2) ? gr.x : gr.y, ghw = (i < 2) ? gh.x : gh.y;
            const int sh = (i & 1) * 16;
            const float rgv = bf2f((bf16_t)((rgw >> sh) & 0xffffu)), hgv = bf2f((bf16_t)((hgw >> sh) & 0xffffu));
            const float grv = bf2f((bf16_t)((grw >> sh) & 0xffffu)), ghv = bf2f((bf16_t)((ghw >> sh) & 0xffffu));
            const float a = dv[i] * rs * wr4[i] * (rgv * sigmoidf_(rgv));
            const float bq = ohv[i] * rs2 * wh4[i] * (hgv * sigmoidf_(hgv));
            o4[i] = sigmoidf_(grv) * a + sigmoidf_(ghv) * bq;
        }
        u32x2 w; w.x = cvt2(o4[0], o4[1]); w.y = cvt2(o4[2], o4[3]);
        *(u32x2*)(p.merged + (size_t)row * DM + c) = w;
    }
}

__device__ __forceinline__ void p5_router(const Params& p, LAS unsigned char* lds, int bid, int nb) {
    const int tid = threadIdx.x, lane = tid & 63, wid = tid >> 6;
    LAS float* hs = (LAS float*)lds;
    LAS float* red = hs + 8 * 2048;
    LAS int* le = (LAS int*)(red + 16 * 8 * 32);
    LAS int* lr = le + 256;
    LAS float* lgt = (LAS float*)(lr + 256);
    for (int t0 = bid * 64; t0 < NT; t0 += nb * 64) {
        for (int it = 0; it < 8; ++it) {
            const int tokl = it * 8 + wid, tok = t0 + tokl;
            {
                const f32x4* xr = (const f32x4*)(p.h2 + (size_t)tok * DM);
                f32x4 v[8]; float ss = 0.f;
#pragma unroll
                for (int i = 0; i < 8; ++i) { v[i] = xr[i * 64 + lane]; ss += v[i][0] * v[i][0] + v[i][1] * v[i][1] + v[i][2] * v[i][2] + v[i][3] * v[i][3]; }
                ss = wave_sum(ss);
                const float rstd = rsqrtf(ss * (1.0f / DM) + 1e-6f);
#pragma unroll
                for (int i = 0; i < 8; ++i) {
                    const f32x4 wv = ((const f32x4*)p.nmoe_w)[i * 64 + lane];
                    const f32x4 o = v[i] * rstd * wv;
                    *(LAS f32x4*)(hs + wid * 2048 + (i * 64 + lane) * 4) = o;
                    u32x2 ob; ob.x = cvt2(o[0], o[1]); ob.y = cvt2(o[2], o[3]);
                    *(u32x2*)(p.hn2 + (size_t)tok * DM + (i * 64 + lane) * 4) = ob;
                }
            }
            __syncthreads();
            {
                const int e = tid & 31, part = tid >> 5;
                float acc[8];
#pragma unroll
                for (int k = 0; k < 8; ++k) acc[k] = 0.f;
                for (int d4 = 0; d4 < 128; d4 += 4) {
                    const int d0 = part * 128 + d4;
                    const float w0 = p.w_router[(size_t)(d0 + 0) * NE + e], w1 = p.w_router[(size_t)(d0 + 1) * NE + e];
                    const float w2 = p.w_router[(size_t)(d0 + 2) * NE + e], w3 = p.w_router[(size_t)(d0 + 3) * NE + e];
#pragma unroll
                    for (int k = 0; k < 8; ++k) { const f32x4 hv = *(const LAS f32x4*)(hs + k * 2048 + d0); acc[k] += hv[0] * w0 + hv[1] * w1 + hv[2] * w2 + hv[3] * w3; }
                }
#pragma unroll
                for (int k = 0; k < 8; ++k) red[(part * 8 + k) * 32 + e] = acc[k];
            }
            __syncthreads();
            {
                float v = -3.0e38f;
                if (lane < 32) { float s = p.b_router[lane];
#pragma unroll
                    for (int part = 0; part < 16; ++part) s += red[(part * 8 + wid) * 32 + lane];
                    v = s; }
                float tv[4]; int te[4];
#pragma unroll
                for (int k = 0; k < 4; ++k) {
                    float bv = v; int bi = lane;
#pragma unroll
                    for (int o = 32; o >= 1; o >>= 1) { const float ov = __shfl_xor(bv, o); const int oi = __shfl_xor(bi, o); if (ov > bv || (ov == bv && oi < bi)) { bv = ov; bi = oi; } }
                    tv[k] = bv; te[k] = bi; if (lane == bi) v = -3.0e38f;
                }
                const float e0 = 1.0f, e1 = __expf(tv[1] - tv[0]), e2 = __expf(tv[2] - tv[0]), e3 = __expf(tv[3] - tv[0]);
                const float inv = 1.0f / (e0 + e1 + e2 + e3);
                if (lane < 4) {
                    const int ee = lane == 0 ? te[0] : lane == 1 ? te[1] : lane == 2 ? te[2] : te[3];
                    const float gg = (lane == 0 ? e0 : lane == 1 ? e1 : lane == 2 ? e2 : e3) * inv;
                    le[tokl * 4 + lane] = ee; lgt[tokl * 4 + lane] = gg;
                }
            }
            __syncthreads();
        }
        if (tid < 32) {
            int c = 0;
            for (int i = 0; i < 256; ++i) if (le[i] == tid) { lr[i] = c; ++c; }
            p.whist[(t0 >> 6) * 32 + tid] = c;
        }
        __syncthreads();
        if (tid < 256) { const int idx = t0 * 4 + tid; p.tk_e[idx] = le[tid]; p.tk_rank[idx] = lr[tid]; p.tk_g[idx] = lgt[tid]; }
        __syncthreads();
    }
}

__device__ __forceinline__ void p6_gather(const Params& p, LAS unsigned char* lds, LAS int* tb, int bid, int nb) {
    const int tid = threadIdx.x, lane = tid & 63, wid = tid >> 6;
    LAS int* pre = (LAS int*)lds;
    if (tid < 32) {
        int run = 0;
        for (int w = 0; w < NT / 64; ++w) { pre[w * 32 + tid] = run; run += p.whist[w * 32 + tid]; }
        tb[128 + 256 + tid] = run;
    }
    __syncthreads();
    if (tid == 0) {
        int t = 0;
        for (int e = 0; e < NE; ++e) {
            const int c = tb[128 + 256 + e], nt = (c + 255) >> 8;
            tb[1 + e] = t * 256;
            for (int k = 0; k < nt; ++k) tb[64 + t + k] = e;
            t += nt;
            if (bid == 0) p.gcnt[e] = c;
        }
        tb[0] = t;
    }
    __syncthreads();
    for (int ent = bid * 8 + wid; ent < NT * 4; ent += nb * 8) {
        const int e = p.tk_e[ent], tok = ent >> 2, dest = tb[1 + e] + pre[(tok >> 6) * 32 + e] + p.tk_rank[ent];
        const u32x4* src = (const u32x4*)(p.hn2 + (size_t)tok * DM); u32x4* dst = (u32x4*)(p.xg + (size_t)dest * DM);
#pragma unroll
        for (int i = 0; i < 4; ++i) dst[i * 64 + lane] = src[i * 64 + lane];
        if (lane == 0) { p.row_gate[dest] = p.tk_g[ent]; p.pos[ent] = dest; }
    }
    for (int e = 0; e < NE; ++e) {
        const int c = tb[128 + 256 + e], r0 = tb[1 + e] + c, r1 = tb[1 + e] + (((c + 255) >> 8) << 8);
        for (int r = r0 + bid * 8 + wid; r < r1; r += nb * 8) {
            u32x4* dst = (u32x4*)(p.xg + (size_t)r * DM);
#pragma unroll
            for (int i = 0; i < 4; ++i) dst[i * 64 + lane] = (u32x4){0u, 0u, 0u, 0u};
            if (lane == 0) p.row_gate[r] = 0.f;
        }
    }
}

__device__ __forceinline__ void p9_final(const Params& p, int bid, int nb) {
    const int lane = threadIdx.x & 63, wid = threadIdx.x >> 6;
    for (int tok = bid * 8 + wid; tok < NT; tok += nb * 8) {
        const f32x4* hr = (const f32x4*)(p.h2 + (size_t)tok * DM);
        const bf16_t* y0 = p.y + (size_t)p.pos[tok * 4 + 0] * DM; const bf16_t* y1 = p.y + (size_t)p.pos[tok * 4 + 1] * DM;
        const bf16_t* y2 = p.y + (size_t)p.pos[tok * 4 + 2] * DM; const bf16_t* y3 = p.y + (size_t)p.pos[tok * 4 + 3] * DM;
        f32x4 v[8]; float ss = 0.f;
#pragma unroll
        for (int i = 0; i < 8; ++i) {
            const int c = (i * 64 + lane) * 4;
            f32x4 a = hr[i * 64 + lane];
#if DBG_SKIP_MOE
            v[i] = a; ss += a[0] * a[0] + a[1] * a[1] + a[2] * a[2] + a[3] * a[3]; continue;
#endif
            const u32x2 q0 = *(const u32x2*)(y0 + c), q1 = *(const u32x2*)(y1 + c), q2 = *(const u32x2*)(y2 + c), q3 = *(const u32x2*)(y3 + c);
            a[0] += (bf2f((bf16_t)(q0.x & 0xffffu)) + bf2f((bf16_t)(q1.x & 0xffffu))) + (bf2f((bf16_t)(q2.x & 0xffffu)) + bf2f((bf16_t)(q3.x & 0xffffu)));
            a[1] += (bf2f((bf16_t)(q0.x >> 16)) + bf2f((bf16_t)(q1.x >> 16))) + (bf2f((bf16_t)(q2.x >> 16)) + bf2f((bf16_t)(q3.x >> 16)));
            a[2] += (bf2f((bf16_t)(q0.y & 0xffffu)) + bf2f((bf16_t)(q1.y & 0xffffu))) + (bf2f((bf16_t)(q2.y & 0xffffu)) + bf2f((bf16_t)(q3.y & 0xffffu)));
            a[3] += (bf2f((bf16_t)(q0.y >> 16)) + bf2f((bf16_t)(q1.y >> 16))) + (bf2f((bf16_t)(q2.y >> 16)) + bf2f((bf16_t)(q3.y >> 16)));
            v[i] = a; ss += a[0] * a[0] + a[1] * a[1] + a[2] * a[2] + a[3] * a[3];
        }
        ss = wave_sum(ss);
        const float rstd = rsqrtf(ss * (1.0f / DM) + 1e-6f);
#pragma unroll
        for (int i = 0; i < 8; ++i) { const f32x4 wv = ((const f32x4*)p.nfin_w)[i * 64 + lane]; ((f32x4*)(p.out + (size_t)tok * DM))[i * 64 + lane] = v[i] * rstd * wv; }
    }
}


#if DIAG
__device__ __forceinline__ unsigned hsh(unsigned a, unsigned b) { unsigned x = a * 0x9E3779B1u + b * 0x85EBCA77u + 0x165667B1u; x ^= x >> 15; x *= 0x2C1B3C6Du; x ^= x >> 12; x *= 0x297A2D39u; x ^= x >> 15; return x; }
__device__ __forceinline__ void dacc(float* diag, int stage, float f, float sv, int lane) { if (lane == 0) { atomicAdd(&diag[2 * stage], (f - sv) * (f - sv)); atomicAdd(&diag[2 * stage + 1], sv * sv); } }
__device__ __forceinline__ float swiglu_ref(float g, float l) { const float xg = fminf(g, 7.0f), xl = fminf(fmaxf(l, -7.0f), 7.0f); return xg * (1.0f / (1.0f + expf(-1.702f * xg))) * (xl + 1.0f); }

__device__ void diag_checks(const Params& p, int bid, int nb) {
    const int lane = threadIdx.x & 63, wid = threadIdx.x >> 6;
    float* diag = p.diag;
    for (int rep = 0; rep < 2; ++rep) {
        const unsigned sid = (unsigned)((bid * 8 + wid) * 2 + rep);
        {
            const int row = hsh(sid, 1) % NT, col = hsh(sid, 2) % DM;
            float ss = 0.f; for (int k = lane; k < DM; k += 64) { const float v = p.x[(size_t)row * DM + k]; ss += v * v; }
            ss = wave_sum(ss);
            const float sv = p.x[(size_t)row * DM + col] * rsqrtf(ss / DM + 1e-6f) * p.nmix_w[col];
            dacc(diag, 0, bf2f(p.hn[(size_t)row * DM + col]), sv, lane);
        }
        {
            const int row = hsh(sid, 3) % NT, col = hsh(sid, 4) % NZ;
            float a = 0.f; for (int k = lane; k < DM; k += 64) a += bf2f(p.hn[(size_t)row * DM + k]) * p.w_in[(size_t)k * NZ + col];
            float v = wave_sum(a);
            if (col < 4096) {
                const int hc = col & 255, pr = hc & 127, partner = (col & ~255) + ((hc + 128) & 255);
                float b = 0.f; for (int k = lane; k < DM; k += 64) b += bf2f(p.hn[(size_t)row * DM + k]) * p.w_in[(size_t)k * NZ + partner];
                const float u = wave_sum(b);
                const int sq = row & (SEQ - 1);
                const double ang = (double)sq * (double)powf(10000.0f, -(float)pr / 127.0f);
                const float cs = (float)cos(ang), sn = (float)sin(ang);
                v = (hc < 128) ? (v * cs - u * sn) : (v * cs + u * sn);
                if (col >= 2048) v *= 0.0625f;
            }
            dacc(diag, 1, bf2f(p.z[(size_t)row * NZ + col]), v, lane);
        }
        {
            int b = hsh(sid, 5) & 3, sq = hsh(sid, 6) % SEQ, h = hsh(sid, 7) & 7, c = hsh(sid, 8) & 255;
            if (DIAG_SUB == 1) sq &= 63;
            if (DIAG_SUB == 2) h = 0;
            if (DIAG_SUB == 3) h = 7;
            if (DIAG_SUB == 4) sq = 64 + (sq & 63);
            const int n = sq >> 6;
            const float lg2 = log2f(1.0f - exp2f(-5.0f - (float)h));
            const bf16_t* zb = p.z + (size_t)(b * SEQ) * NZ;
            float q[4];
            for (int t = 0; t < 4; ++t) q[t] = bf2f(zb[(size_t)sq * NZ + h * 256 + lane * 4 + t]);
            float acc = 0.f;
            for (int m = 0; m < 64 * (n + 1); ++m) {
                float d = 0.f;
                for (int t = 0; t < 4; ++t) d += q[t] * bf2f(zb[(size_t)m * NZ + 2048 + h * 256 + lane * 4 + t]);
                d = wave_sum(d);
                const float w = exp2f(fabsf((float)(sq - m)) * lg2);
                acc += w * d * bf2f(zb[(size_t)m * NZ + 4096 + h * 256 + c]);
            }
            dacc(diag, 2, p.o_r[(size_t)(b * SEQ + sq) * DM + h * 256 + c], acc, lane);
        }
        {
            const int b = hsh(sid, 9) & 3, sq = hsh(sid, 10) % SEQ, h = hsh(sid, 11) & 15, c = hsh(sid, 12) & 127;
            const bf16_t* zb = p.z + (size_t)(b * SEQ) * NZ;
            float lbv[2], qs[2], run[2];
            for (int t = 0; t < 2; ++t) {
                const int d = h * 128 + lane * 2 + t;
                lbv[t] = 1.0f / (1.0f + expf(p.lb_logits[DM + d] - p.lb_logits[d]));
                const float qv = bf2f(zb[(size_t)sq * NZ + 8192 + d]); qs[t] = qv / (1.0f + expf(-qv)); run[t] = 0.f;
            }
            float acc = 0.f;
            const int mlo = sq > 300 ? sq - 300 : 0;
            for (int m = sq; m >= mlo; --m) {
                float term = 0.f, lf[2];
                for (int t = 0; t < 2; ++t) {
                    const float zf = bf2f(zb[(size_t)m * NZ + 10240 + h * 128 + lane * 2 + t]);
                    const float sg = 1.0f / (1.0f + expf(-zf)), f = lbv[t] + (1.0f - lbv[t]) * sg;
                    term += qs[t] * (1.0f - f) * expf(run[t]); lf[t] = logf(f);
                }
                term = wave_sum(term);
                acc += term * bf2f(zb[(size_t)m * NZ + 12288 + h * 128 + c]);
                run[0] += lf[0]; run[1] += lf[1];
            }
            dacc(diag, 3, p.o_h[(size_t)(b * SEQ + sq) * DM + h * 128 + c], acc, lane);
        }
        {
            const int row = hsh(sid, 13) % NT, col = hsh(sid, 14) % DM;
            const int rh = col >> 8, hh = col >> 7;
            float s1 = 0.f; for (int t = 0; t < 4; ++t) s1 += p.o_r[(size_t)row * DM + rh * 256 + lane * 4 + t];
            const float mean = wave_sum(s1) / 256.0f;
            float s2 = 0.f; for (int t = 0; t < 4; ++t) { const float dd = p.o_r[(size_t)row * DM + rh * 256 + lane * 4 + t] - mean; s2 += dd * dd; }
            const float rs = rsqrtf(wave_sum(s2) / 256.0f + 1e-6f);
            float s3 = 0.f; for (int t = 0; t < 2; ++t) { const float v = p.o_h[(size_t)row * DM + hh * 128 + lane * 2 + t]; s3 += v * v; }
            const float rs2 = rsqrtf(wave_sum(s3) / 128.0f + 1e-6f);
            const bf16_t* zr = p.z + (size_t)row * NZ;
            const float rg = bf2f(zr[6144 + col]), hg = bf2f(zr[14336 + col]), gr = bf2f(zr[16384 + col]), gh = bf2f(zr[18432 + col]);
            const float a = (p.o_r[(size_t)row * DM + col] - mean) * rs * p.ret_nw[col] * (rg / (1.0f + expf(-rg)));
            const float bq = p.o_h[(size_t)row * DM + col] * rs2 * p.hg_nw[col] * (hg / (1.0f + expf(-hg)));
            const float sv = a / (1.0f + expf(-gr)) + bq / (1.0f + expf(-gh));
            dacc(diag, 4, bf2f(p.merged[(size_t)row * DM + col]), sv, lane);
        }
        {
            const int row = hsh(sid, 15) % NT, col = hsh(sid, 16) % DM;
            float a = 0.f; for (int k = lane; k < DM; k += 64) a += bf2f(p.merged[(size_t)row * DM + k]) * p.w_out[(size_t)k * DM + col];
            const float sv = wave_sum(a) + p.x[(size_t)row * DM + col];
            dacc(diag, 5, p.h2[(size_t)row * DM + col], sv, lane);
        }
        {
            const int tok = hsh(sid, 17) % NT;
            float ss = 0.f; for (int k = lane; k < DM; k += 64) { const float v = p.h2[(size_t)tok * DM + k]; ss += v * v; }
            const float rstd = rsqrtf(wave_sum(ss) / DM + 1e-6f);
            const int e = lane & 31, half = lane >> 5;
            float a = 0.f;
            for (int d = half * 1024; d < half * 1024 + 1024; ++d) a += p.h2[(size_t)tok * DM + d] * rstd * p.nmoe_w[d] * p.w_router[(size_t)d * NE + e];
            a += __shfl_xor(a, 32);
            const float lg = a + p.b_router[e];
            int rank = 0; float mx = -3.0e38f;
            for (int o = 0; o < 32; ++o) { const float ov = __shfl(lg, o); if (ov > lg || (ov == lg && o < e)) ++rank; mx = fmaxf(mx, ov); }
            float den = 0.f;
            for (int o = 0; o < 32; ++o) { const float ov = __shfl(lg, o); const int orank = __shfl(rank, o); if (orank < 4) den += expf(ov - mx); }
            const float gate = expf(lg - mx) / den;
            for (int k = 0; k < 4; ++k) {
                const int fe = p.tk_e[tok * 4 + k]; const float fg = p.tk_g[tok * 4 + k];
                const int srank = __shfl(rank, fe & 31); const float sg = __shfl(gate, fe & 31);
                const float fv = (srank == k && fe >= 0 && fe < 32) ? fg : fg + 1.0f;
                dacc(diag, 6, fv, sg, lane);
            }
        }
        {
            const int ent = hsh(sid, 18) % (NT * 4), tok = ent >> 2, e = p.tk_e[ent], dest = p.pos[ent];
            int rstart = 0; for (int q = 0; q < e; ++q) rstart += ((p.gcnt[q] + 255) >> 8) << 8;
            int bad = (dest < rstart || dest >= rstart + p.gcnt[e]) ? 1 : 0;
            for (int k = lane; k < DM; k += 64) if (p.xg[(size_t)dest * DM + k] != p.hn2[(size_t)tok * DM + k]) bad = 1;
            if (p.row_gate[dest] != p.tk_g[ent]) bad = 1;
            for (int o = 32; o >= 1; o >>= 1) bad |= __shfl_xor(bad, o);
            dacc(diag, 7, bad ? 2.0f : 1.0f, 1.0f, lane);
            {
                const int j = hsh(sid, 19) % DFF;
                const float* w1e = p.w1 + (size_t)e * DM * 4096;
                float g = 0.f, l = 0.f;
                for (int k = lane; k < DM; k += 64) { const float xv = bf2f(p.xg[(size_t)dest * DM + k]); g += xv * w1e[(size_t)k * 4096 + 2 * j]; l += xv * w1e[(size_t)k * 4096 + 2 * j + 1]; }
                g = wave_sum(g) + p.b1[e * 4096 + 2 * j]; l = wave_sum(l) + p.b1[e * 4096 + 2 * j + 1];
                dacc(diag, 8, bf2f(p.hid[(size_t)dest * DFF + j]), swiglu_ref(g, l), lane);
            }
            {
                const int col = hsh(sid, 20) % DM;
                const float* w2e = p.w2 + (size_t)e * DFF * DM;
                float a = 0.f; for (int k = lane; k < DFF; k += 64) a += bf2f(p.hid[(size_t)dest * DFF + k]) * w2e[(size_t)k * DM + col];
                const float sv = (wave_sum(a) + p.b2[e * DM + col]) * p.row_gate[dest];
                dacc(diag, 9, bf2f(p.y[(size_t)dest * DM + col]), sv, lane);
            }
        }
        {
            const int tok = hsh(sid, 21) % NT, col = hsh(sid, 22) % DM;
            float ss = 0.f, mine = 0.f;
            for (int k = lane; k < DM; k += 64) {
                float v = p.h2[(size_t)tok * DM + k];
                for (int q = 0; q < 4; ++q) v += bf2f(p.y[(size_t)p.pos[tok * 4 + q] * DM + k]);
                ss += v * v; if (k == col) mine = v;
            }
            ss = wave_sum(ss); mine = wave_sum(mine);
            dacc(diag, 10, p.out[(size_t)tok * DM + col], mine * rsqrtf(ss / DM + 1e-6f) * p.nfin_w[col], lane);
        }
    }
}
__device__ void diag_finalize(const Params& p, int bid, int nb) {
    int fail = -1;
    for (int s = 0; s <= 10; ++s) { const float num = p.diag[2 * s], den = p.diag[2 * s + 1]; if (fail < 0 && !(num <= DIAG_THR * DIAG_THR * den)) fail = s; }
    float V = (fail < 0) ? 10.0f : 12.0f + 2.0f * (float)fail;
#if DIAG == 2
    { const float num = p.diag[2 * DIAG_STAGE], den = p.diag[2 * DIAG_STAGE + 1]; const float err = sqrtf(num / fmaxf(den, 1e-30f));
      const float num2 = p.diag[2 * DIAG_STAGE2], den2 = p.diag[2 * DIAG_STAGE2 + 1]; const float err2 = sqrtf(num2 / fmaxf(den2, 1e-30f));
      const int a = (int)fminf(8.0f, floorf(err * 20.0f)), b2 = (int)fminf(9.0f, floorf(err2 * 20.0f)); V = 10.0f * (float)(1 + a) + (float)b2; }
#endif
    const float c = sqrtf((V - 1.0f) * 1.01f);
    for (size_t i = (size_t)bid * NTHREADS + threadIdx.x; i < (size_t)NT * DM; i += (size_t)nb * NTHREADS) p.out[i] = (i & 1) ? -c : c;
}
#endif

constexpr int NPHASE = 10;
__global__ void __launch_bounds__(NTHREADS, 2) fwd(Params p) {
    extern __shared__ __attribute__((aligned(16))) unsigned char shm[];
    LAS unsigned char* lds = (LAS unsigned char*)shm;
    LAS int* tb = (LAS int*)(lds + XTRA_OFF);
    volatile LAS unsigned* bst = (volatile LAS unsigned*)(lds + XTRA_OFF + 3072);
    const int lo = (int)(p.lo_hi & 0xffffffffll), hi = (int)(p.lo_hi >> 32);
    const int bid = blockIdx.x, nb = gridDim.x;
    if (threadIdx.x == 0) { bst[0] = 0u; bst[1] = 0u; bst[2] = 0u; bst[3] = 0u; }
    __syncthreads();
    XcdBarrier bar; bar.bar = p.bar; bar.x = 0; bar.st = bst;
    const bool multi = (hi - lo) > 1;
    if (multi) bar = xcd_barrier_post(p.bar, bst);
#define IN(k) (lo <= (k) && (k) < hi)
#define SEAM(k) do { if (IN(k) && IN((k) + 1)) xcd_barrier(bar); } while (0)

    if (IN(0)) { p0_prologue(p, lds, bid, nb); }
    SEAM(0);
    if (IN(1)) {
        pg8::Gemm g{p.hn, p.w_in_t, NT, NZ, DM}; pg8::StaticOrder S; S.init(NT, NZ, nb, bid);
        EpiZ E{p.z, p.cosT, p.sinT};
        pg8::gemm_phase<EpiZ, pg8::StaticOrder>(lds, g, S, E);
    }
    SEAM(1);
    if (IN(2)) {
        for (int u = bid; u < 256; u += nb) { mixer_ret(p, lds, u); }
        for (int u = bid; u < 256; u += nb) { mixer_hg(p, lds, u); }
    }
    SEAM(2);
    if (IN(3)) { p3_merge(p, bid, nb); }
    SEAM(3);
    if (IN(4)) {
        pg8::Gemm g{p.merged, p.w_out_t, NT, DM, DM}; pg8::StaticOrder S; S.init(NT, DM, nb, bid);
        EpiRes E{p.h2, p.x};
        pg8::gemm_phase<EpiRes, pg8::StaticOrder>(lds, g, S, E);
    }
    SEAM(4);
    if (IN(5)) { p5_router(p, lds, bid, nb); }
    SEAM(5);
    if (IN(6)) { p6_gather(p, lds, tb, bid, nb); }
    SEAM(6);
    if (IN(7)) {
        build_tiles(p, tb);
        pg8::Gemm g{p.xg, p.w1t, MAXROWS, 4096, DM}; MoeOrder S; S.init(tb[0], 16, nb, bid, tb + 64);
        EpiSwiglu E{p.hid, p.b1p};
        pg8::gemm_phase<EpiSwiglu, MoeOrder>(lds, g, S, E);
    }
    SEAM(7);
    if (IN(8)) {
        build_tiles(p, tb);
        pg8::Gemm g{p.hid, p.w2t, MAXROWS, DM, DFF}; MoeOrder S; S.init(tb[0], 8, nb, bid, tb + 64);
        EpiY E{p.y, p.b2, p.row_gate};
        pg8::gemm_phase<EpiY, MoeOrder>(lds, g, S, E);
    }
    SEAM(8);
    if (IN(9)) { p9_final(p, bid, nb); }
#if DIAG
    if (IN(10)) { diag_checks(p, bid, nb); }
    if (IN(11)) { diag_finalize(p, bid, nb); }
#endif
#undef IN
#undef SEAM
}

extern "C" void kernel_launch(void* const* d_in, const int* in_sizes, int n_in, void* d_out, int out_size, void* d_ws, size_t ws_size, hipStream_t stream) {
    static int grid = 0;
    if (grid == 0) {
        int dev = 0, cus = 0;
        if (hipGetDevice(&dev) != hipSuccess || hipDeviceGetAttribute(&cus, hipDeviceAttributeMultiprocessorCount, dev) != hipSuccess) { fprintf(stderr, "kernel_launch: device query failed\n"); grid = -1; return; }
        if (hipFuncSetAttribute((const void*)fwd, hipFuncAttributeMaxDynamicSharedMemorySize, LDS_BYTES) != hipSuccess) { fprintf(stderr, "kernel_launch: hipFuncSetAttribute failed\n"); grid = -1; return; }
        int per_cu = 0;
        if (hipOccupancyMaxActiveBlocksPerMultiprocessor(&per_cu, (const void*)fwd, NTHREADS, LDS_BYTES) != hipSuccess || per_cu < 1) fprintf(stderr, "kernel_launch: occupancy query says %d\n", per_cu);
        (void)hipGetLastError();
        grid = cus > 0 ? cus : 256;
    }
    if (grid < 0) return;
    unsigned char* ws = (unsigned char*)d_ws;
    size_t off = 0;
    auto take = [&](size_t bytes) { unsigned char* r = ws + off; off += (bytes + 255) & ~(size_t)255; return r; };
    Params p{};
    p.x = (const float*)d_in[0]; p.w_in = (const float*)d_in[1]; p.ret_nw = (const float*)d_in[2]; p.hg_nw = (const float*)d_in[3]; p.lb_logits = (const float*)d_in[4];
    p.w_out = (const float*)d_in[5]; p.nmix_w = (const float*)d_in[6]; p.nmoe_w = (const float*)d_in[7]; p.w_router = (const float*)d_in[8]; p.b_router = (const float*)d_in[9];
    p.w1 = (const float*)d_in[10]; p.b1 = (const float*)d_in[11]; p.w2 = (const float*)d_in[12]; p.b2 = (const float*)d_in[13]; p.nfin_w = (const float*)d_in[14];
    p.out = (float*)d_out;
    p.bar = (unsigned*)take(XCD_BAR_WORDS * 4);
    p.diag = (float*)take(256);
    p.gcnt = (int*)take(256);
    p.whist = (int*)take((NT / 64) * 32 * 4);
    p.w_in_t = (bf16_t*)take((size_t)NZ * DM * 2);
    p.w_out_t = (bf16_t*)take((size_t)DM * DM * 2);
    p.w1t = (bf16_t*)take((size_t)NE * 4096 * DM * 2);
    p.w2t = (bf16_t*)take((size_t)NE * DM * DFF * 2);
    p.hn = (bf16_t*)take((size_t)NT * DM * 2);
    p.z = (bf16_t*)take((size_t)NT * NZ * 2);
    p.merged = (bf16_t*)take((size_t)NT * DM * 2);
    p.hn2 = (bf16_t*)take((size_t)NT * DM * 2);
    p.xg = (bf16_t*)take((size_t)MAXROWS * DM * 2);
    p.hid = (bf16_t*)take((size_t)MAXROWS * DFF * 2);
    p.y = (bf16_t*)take((size_t)MAXROWS * DM * 2);
    p.o_r = (float*)take((size_t)NT * DM * 4);
    p.o_h = (float*)take((size_t)NT * DM * 4);
    p.h2 = (float*)take((size_t)NT * DM * 4);
    p.cosT = (float*)take((size_t)SEQ * 128 * 4);
    p.sinT = (float*)take((size_t)SEQ * 128 * 4);
    p.b1p = (float*)take((size_t)NE * 4096 * 4);
    p.tk_g = (float*)take((size_t)NT * 4 * 4);
    p.row_gate = (float*)take((size_t)MAXROWS * 4);
    p.tk_e = (int*)take((size_t)NT * 4 * 4);
    p.tk_rank = (int*)take((size_t)NT * 4 * 4);
    p.pos = (int*)take((size_t)NT * 4 * 4);
    if (off > ws_size) { fprintf(stderr, "kernel_launch: workspace too small: need %zu, have %zu\n", off, ws_size); return; }
    (void)hipMemsetAsync(p.bar, 0, XCD_BAR_WORDS * 4 + 256, stream);
#if N_LAUNCH_MODE == 1
    p.lo_hi = ((long long)NPHASE << 32) | 0ll;
    hipLaunchKernelGGL(fwd, dim3(grid), dim3(NTHREADS), LDS_BYTES, stream, p);
#else
    for (int ph = 0; ph < NPHASE + (DIAG ? 2 : 0); ++ph) {
        if (DBG_SKIP_MOE && ph >= 5 && ph <= 8) continue;
        p.lo_hi = ((long long)(ph + 1) << 32) | (long long)ph;
        hipLaunchKernelGGL(fwd, dim3(grid), dim3(NTHREADS), LDS_BYTES, stream, p);
    }
#endif
    const hipError_t le = hipPeekAtLastError();
    if (le != hipSuccess) fprintf(stderr, "kernel_launch: launch failed: %s\n", hipGetErrorName(le));
}
```

```cpp
#include <hip/hip_runtime.h>
#include <cstdio>
#include <cstdint>

#ifndef DBG_SKIP_MOE
#define DBG_SKIP_MOE 0
#endif
#ifndef DIAG
#define DIAG 0
#endif
#ifndef DIAG_THR
#define DIAG_THR 0.10f
#endif
#ifndef TS_Q
#define TS_Q 70.0f
#endif
#ifndef TS_A0
#define TS_A0 2
#define TS_A1 3
#define TS_B0 3
#define TS_B1 4
#endif
#ifndef DIAG_SUB
#define DIAG_SUB 4
#endif
#ifndef DIAG_STAGE2
#define DIAG_STAGE2 3
#endif
#ifndef DIAG_STAGE
#define DIAG_STAGE 2
#endif
#ifndef P1_FP8
#define P1_FP8 0
#endif
#ifndef P1_MIX
#define P1_MIX 1
#endif
#ifndef N_LAUNCH_MODE
#define N_LAUNCH_MODE 1
#endif

#define LAS __attribute__((address_space(3)))
typedef unsigned short bf16_t;
typedef short bf16x8 __attribute__((ext_vector_type(8)));
typedef float f32x4 __attribute__((ext_vector_type(4)));
typedef unsigned u32x4 __attribute__((ext_vector_type(4)));
typedef unsigned u32x2 __attribute__((ext_vector_type(2)));

constexpr int NT = 16384, DM = 2048, NZ = 20480, SEQ = 4096, NE = 32, DFF = 2048;
constexpr int MAXROWS = 65536 + NE * 256;
constexpr int MAXMT = MAXROWS / 256;
constexpr int NTHREADS = 512;
constexpr float W_SCALE = 1024.0f, X_SCALE = 16.0f, H_SCALE = 4.0f, Y_SCALE = 16.0f;
constexpr int STAGE_LDS = 131072;
constexpr int MIX_LDS = 139776;
constexpr int XTRA_OFF = 152576;
constexpr int LDS_BYTES = XTRA_OFF + 4096;

#define XB_TMO      128
#define XB_XCNT(j)  (256  + 64 * (j))
#define XB_XSUB(j)  (1280 + 64 * (j))
#define XB_XGEN(j)  (2304 + 64 * (j))
#define XB_TOP      3328
#define XB_TOPGEN   3392
#define XCD_BAR_WORDS 3456
#define XB_SPIN_CAP (1u << 22)

__device__ __forceinline__ unsigned xb_ld(unsigned* p)              { return __hip_atomic_load(p, __ATOMIC_RELAXED, __HIP_MEMORY_SCOPE_AGENT); }
__device__ __forceinline__ unsigned xb_add(unsigned* p, unsigned v) { return __hip_atomic_fetch_add(p, v, __ATOMIC_RELAXED, __HIP_MEMORY_SCOPE_AGENT); }
__device__ __forceinline__ unsigned xb_xcc_id() { return (unsigned)__builtin_amdgcn_s_getreg((3 << 11) | 20) & 0xFu; }
#define XB_SPIN(cond, bar) do { unsigned _sp = 0; while (cond) { __builtin_amdgcn_s_sleep(1); \
    if ((++_sp & 255u) == 0u) { if (xb_ld(&(bar)[XB_TMO])) break; if (_sp > XB_SPIN_CAP) { atomicAdd(&(bar)[XB_TMO], 1u); break; } } } } while (0)

struct XcdBarrier { unsigned* bar; unsigned x; volatile LAS unsigned* st; };

__device__ __forceinline__ XcdBarrier xcd_barrier_post(unsigned* bar, volatile LAS unsigned* st) {
    XcdBarrier b; b.bar = bar; b.x = xb_xcc_id(); b.st = st;
    if (threadIdx.x == 0) (void)xb_add(&bar[XB_XCNT(b.x)], 1u);
    return b;
}
__device__ __forceinline__ void xcd_barrier_complete(unsigned* bar, unsigned x, unsigned& nloc, unsigned& nx) {
    const unsigned G = gridDim.x * gridDim.y * gridDim.z;
    unsigned sum, cnt, mine, sp = 0u;
    for (;;) {
        sum = 0u; cnt = 0u; mine = 0u;
#pragma unroll
        for (unsigned j = 0; j < 16; ++j) { const unsigned c = xb_ld(&bar[XB_XCNT(j)]); sum += c; cnt += (c > 0u) ? 1u : 0u; mine = (j == x) ? c : mine; }
        if (sum == G) break;
        __builtin_amdgcn_s_sleep(1);
        if ((++sp & 255u) == 0u) { if (xb_ld(&bar[XB_TMO])) break; if (sp > XB_SPIN_CAP) { atomicAdd(&bar[XB_TMO], 1u); break; } }
    }
    nloc = mine > 0u ? mine : 1u; nx = cnt > 0u ? cnt : 1u;
}
__device__ __forceinline__ void xcd_barrier(const XcdBarrier& b) {
    asm volatile("s_waitcnt vmcnt(0)" ::: "memory");
    __syncthreads();
    if (threadIdx.x == 0) {
        unsigned* bar = b.bar;
        __builtin_amdgcn_s_waitcnt(0);
        unsigned nloc = b.st[0], nx = b.st[1];
        if (nloc == 0u) { xcd_barrier_complete(bar, b.x, nloc, nx); b.st[0] = nloc; b.st[1] = nx; }
        const unsigned old = xb_add(&bar[XB_XSUB(b.x)], 1u);
        const unsigned gen = old / nloc;
        if (old + 1u == (gen + 1u) * nloc) {
            __builtin_amdgcn_fence(__ATOMIC_RELEASE, "agent");
            asm volatile("s_waitcnt vmcnt(0)" ::: "memory");
            const unsigned og = xb_add(&bar[XB_TOP], 1u);
            const unsigned tg = og / nx;
            if (og + 1u == (tg + 1u) * nx) xb_add(&bar[XB_TOPGEN], 1u);
            else XB_SPIN(xb_ld(&bar[XB_TOPGEN]) == tg, bar);
            __builtin_amdgcn_fence(__ATOMIC_ACQUIRE, "agent");
            xb_add(&bar[XB_XGEN(b.x)], 1u);
            asm volatile("s_waitcnt vmcnt(0)" ::: "memory");
        } else {
            XB_SPIN(xb_ld(&bar[XB_XGEN(b.x)]) == gen, bar);
            __builtin_amdgcn_fence(__ATOMIC_ACQUIRE, "agent");
            asm volatile("s_waitcnt vmcnt(0)" ::: "memory");
        }
    }
    __syncthreads();
}

namespace pg8 {
#define PG8_LAS __attribute__((address_space(3)))
constexpr int BM = 256, BK = 64, HALF = 128, HTB = HALF * BK * 2, STAGE_BYTES = 8 * HTB, NXCD = 8, WGM = 8;
__host__ __device__ __forceinline__ int lds_byte(int r, int c) { const int st = (r >> 4) * 2 + (c >> 5), rr = r & 15, cc = c & 31, ob = rr * 64 + cc * 2; return st * 1024 + (ob ^ (((ob >> 9) & 1) << 5)); }
__host__ __device__ __forceinline__ void stage_rc(int b, int& R, int& C) { const int st = b / 1024, sb = b % 1024, swz = sb ^ (((sb >> 9) & 1) << 5); R = (st >> 1) * 16 + swz / 64; C = (st & 1) * 32 + (swz % 64) / 2; }
__host__ __device__ __forceinline__ int perm32(int rho) { const int n = rho >> 4, i = rho & 15; return 8 * (i >> 2) + 4 * n + (i & 3); }
struct Unit { int pm, pn; };
struct Gemm { const bf16_t* A; const bf16_t* Bt; int M, N, K; };
struct StaticOrder {
    int nM, nN, nwg, G, c;
    __host__ __device__ void init(int M, int N, int G_, int c_) { nM = M / BM; nN = N / BM; nwg = nM * nN; G = G_; c = c_; }
    __host__ __device__ bool next(int i, Unit& u) const {
        const long L = (long)i * G + c; if (L >= nwg) return false;
        int wgid = (int)L; { const int q = nwg / NXCD, r = nwg % NXCD, xcd = wgid % NXCD, off = wgid / NXCD; wgid = (xcd < r ? xcd * (q + 1) : r * (q + 1) + (xcd - r) * q) + off; }
        const int nig = WGM * nN, gid = wgid / nig, fm = gid * WGM, gsz = (nM - fm) < WGM ? (nM - fm) : WGM;
        u.pm = fm + ((wgid % nig) % gsz); u.pn = (wgid % nig) / gsz; return true;
    }
    __device__ __forceinline__ void a_ready(const Unit&) const {}
    __device__ __forceinline__ void done(const Unit&) const {}
    static constexpr bool GATHER = false; const int* rowtok;
};
typedef int i32x8 __attribute__((ext_vector_type(8)));
typedef int i32x4 __attribute__((ext_vector_type(4)));
__device__ __forceinline__ i32x8 cat8(bf16x8 a, bf16x8 b) { return __builtin_shufflevector(__builtin_bit_cast(i32x4, a), __builtin_bit_cast(i32x4, b), 0, 1, 2, 3, 4, 5, 6, 7); }
__device__ __forceinline__ unsigned cvt_pk_bf16(float lo, float hi) { unsigned r; asm volatile("v_cvt_pk_bf16_f32 %0, %1, %2" : "=v"(r) : "v"(lo), "v"(hi)); return r; }

template <class Epi, class Sched>
__device__ __forceinline__ void gemm_phase(PG8_LAS unsigned char* lds, const Gemm g, const Sched& S, const Epi& E) {
    const int tid = threadIdx.x, wid = __builtin_amdgcn_readfirstlane(tid >> 6), lane = tid & 63, wr = wid >> 2, wc = wid & 3, fr = lane & 15, fq = lane >> 4;
    const int K = g.K, nt = K / BK;
    unsigned voffA[2], voffB[2];
#pragma unroll
    for (int i = 0; i < 2; ++i) { int R, C; stage_rc(tid * 16 + i * 8192, R, C); const int Rb = Epi::PERM ? ((R & ~31) + perm32(R & 31)) : R;
        voffA[i] = (unsigned)(R * K + C) * 2u; voffB[i] = (unsigned)(Rb * K + C) * 2u; }
    constexpr bool GA = Sched::GATHER;
    unsigned vgC0[2] = {0u, 0u}, vgC1[2] = {0u, 0u}, vgN0[2] = {0u, 0u}, vgN1[2] = {0u, 0u};
#define PG8_GOFF(U, d0, d1) do { _Pragma("unroll") for (int _i = 0; _i < 2; ++_i) { int _R, _C; stage_rc(tid * 16 + _i * 8192, _R, _C); const int _b = (U).pm * 256 + _R; \
        d0[_i] = (unsigned)S.rowtok[_b] * (unsigned)(K * 2) + (unsigned)(_C * 2); d1[_i] = (unsigned)S.rowtok[_b + 128] * (unsigned)(K * 2) + (unsigned)(_C * 2); } } while (0)
#define PG8_STAGE_A(bufoff, gbase, H, o0, o1) do { if constexpr (GA) { if (H) PG8_STAGE(bufoff, gbase, o1); else PG8_STAGE(bufoff, gbase, o0); } \
        else { PG8_STAGE(bufoff, (gbase) + ((H) ? hstep : (size_t)0), voffA); } } while (0)
    const size_t kstep = (size_t)(BK * 2);
    const size_t hstep = (size_t)HALF * K * 2;
    const size_t tstep = 2 * hstep;
    const unsigned ldsw = (unsigned)wid * 1024u;
    const int aoff = lds_byte(wr * 64 + fr, fq * 8), boff = lds_byte(wc * 32 + fr, fq * 8);
#define PG8_SA(b, h) (((b) * 2 + (h)) * HTB)
#define PG8_SB(b, h) ((4 + (b) * 2 + (h)) * HTB)
#define PG8_STAGE(bufoff, gbase, voff) do { _Pragma("unroll") for (int _i = 0; _i < 2; ++_i) \
        __builtin_amdgcn_global_load_lds((const unsigned*)((const char*)(gbase) + (voff)[_i]), (PG8_LAS unsigned*)(lds + (bufoff) + ldsw + _i * 8192), 16, 0, 0); } while (0)
#define PG8_LDA(dst, b, h) do { _Pragma("unroll") for (int m = 0; m < 4; ++m) { \
        if constexpr (Epi::FP8) { const i32x4 _lo = *(const PG8_LAS i32x4*)(lds + PG8_SA(b, h) + aoff + m * 2048), _hi = *(const PG8_LAS i32x4*)(lds + PG8_SA(b, h) + aoff + m * 2048 + 1024); dst##8[m] = __builtin_shufflevector(_lo, _hi, 0, 1, 2, 3, 4, 5, 6, 7); } \
        else { _Pragma("unroll") for (int k = 0; k < 2; ++k) dst[m][k] = *(const PG8_LAS bf16x8*)(lds + PG8_SA(b, h) + aoff + m * 2048 + k * 1024); } } } while (0)
#define PG8_LDB(dst, b, h) do { _Pragma("unroll") for (int n = 0; n < 2; ++n) { \
        if constexpr (Epi::FP8) { const i32x4 _lo = *(const PG8_LAS i32x4*)(lds + PG8_SB(b, h) + boff + n * 2048), _hi = *(const PG8_LAS i32x4*)(lds + PG8_SB(b, h) + boff + n * 2048 + 1024); dst##8[n] = __builtin_shufflevector(_lo, _hi, 0, 1, 2, 3, 4, 5, 6, 7); } \
        else { _Pragma("unroll") for (int k = 0; k < 2; ++k) dst[n][k] = *(const PG8_LAS bf16x8*)(lds + PG8_SB(b, h) + boff + n * 2048 + k * 1024); } } } while (0)
#define PG8_MMA(ai, bj, At, Bt) do { __builtin_amdgcn_s_setprio(1); _Pragma("unroll") for (int m = 0; m < 4; ++m) _Pragma("unroll") for (int n = 0; n < 2; ++n) { \
        if constexpr (Epi::FP8) { asm volatile("v_mfma_scale_f32_16x16x128_f8f6f4 %0, %1, %2, %0, %3, %3 op_sel_hi:[0,0,0]" : "+v"(acc[ai][bj][m][n]) : "v"(Bt##8[n]), "v"(At##8[m]), "v"(f8scale)); } \
        else { _Pragma("unroll") for (int k = 0; k < 2; ++k) acc[ai][bj][m][n] = __builtin_amdgcn_mfma_f32_16x16x32_bf16(Bt[n][k], At[m][k], acc[ai][bj][m][n], 0, 0, 0); } } \
        __builtin_amdgcn_s_setprio(0); } while (0)
#define PG8_WAIT_V(n) asm volatile("s_waitcnt vmcnt(" #n ")" ::: "memory")
#define PG8_WAIT_L(n) asm volatile("s_waitcnt lgkmcnt(" #n ")" ::: "memory")
#define PG8_BAR __builtin_amdgcn_s_barrier()
#define PG8_SCHED __builtin_amdgcn_sched_barrier(0)
    Unit cur, nxt; int ui = 0;
    if (!S.next(0, cur)) return;
    f32x4 acc[2][2][4][2];
#pragma unroll
    for (int a = 0; a < 2; ++a)
#pragma unroll
        for (int b = 0; b < 2; ++b)
#pragma unroll
            for (int m = 0; m < 4; ++m)
#pragma unroll
                for (int n = 0; n < 2; ++n) acc[a][b][m][n] = (f32x4){0.f, 0.f, 0.f, 0.f};
    bf16x8 At[4][2], B0[2][2], B1[2][2];
    i32x8 At8[4], B08[2], B18[2];
    const int f8scale = 0x7F7F7F7F;
    const char* cA = (const char*)g.A + (GA ? (size_t)0 : (size_t)cur.pm * tstep); const char* cB = (const char*)g.Bt + (size_t)cur.pn * tstep;
    S.a_ready(cur);
    if constexpr (GA) { PG8_GOFF(cur, vgC0, vgC1); vgN0[0] = vgC0[0]; vgN0[1] = vgC0[1]; vgN1[0] = vgC1[0]; vgN1[1] = vgC1[1]; }
    PG8_STAGE(PG8_SB(0, 0), cB, voffB); PG8_STAGE_A(PG8_SA(0, 0), cA, 0, vgC0, vgC1); PG8_STAGE(PG8_SB(0, 1), cB + hstep, voffB); PG8_STAGE_A(PG8_SA(0, 1), cA, 1, vgC0, vgC1);
    if (wr == 1) PG8_BAR;
    PG8_WAIT_V(4); PG8_BAR;
    PG8_STAGE(PG8_SB(1, 0), cB + kstep, voffB); PG8_STAGE_A(PG8_SA(1, 0), cA + kstep, 0, vgC0, vgC1); PG8_STAGE(PG8_SB(1, 1), cB + hstep + kstep, voffB);
    PG8_WAIT_V(6); PG8_BAR;
    for (;;) {
        const bool has_next = S.next(ui + 1, nxt);
        const char* nA = (has_next && !GA) ? (const char*)g.A + (size_t)nxt.pm * tstep : cA; const char* nB = has_next ? (const char*)g.Bt + (size_t)nxt.pn * tstep : cB;
        for (int t = 0; t < nt; t += 2) {
            const bool last = (t == nt - 2);
            const char* a1 = cA + (size_t)(t + 1) * kstep;
            const char* a2 = last ? nA : cA + (size_t)(t + 2) * kstep; const char* b2 = last ? nB : cB + (size_t)(t + 2) * kstep;
            const char* a3 = a2 + kstep; const char* b3 = b2 + kstep;
            if (last && has_next) S.a_ready(nxt);
            unsigned s0[2] = {0u, 0u}, s1[2] = {0u, 0u};
            if constexpr (GA) { if (last && has_next) PG8_GOFF(nxt, vgN0, vgN1);
                s0[0] = last ? vgN0[0] : vgC0[0]; s0[1] = last ? vgN0[1] : vgC0[1]; s1[0] = last ? vgN1[0] : vgC1[0]; s1[1] = last ? vgN1[1] : vgC1[1]; }
            PG8_LDB(B0, 0, 0); PG8_SCHED; PG8_LDA(At, 0, 0); PG8_STAGE_A(PG8_SA(1, 1), a1, 1, vgC0, vgC1);
            PG8_WAIT_L(8); PG8_BAR; PG8_WAIT_L(0); PG8_MMA(0, 0, At, B0); PG8_BAR; PG8_SCHED;
            PG8_LDB(B1, 0, 1); PG8_STAGE(PG8_SB(0, 0), b2, voffB);
            PG8_BAR; PG8_WAIT_L(0); PG8_MMA(0, 1, At, B1); PG8_BAR;
            PG8_LDA(At, 0, 1); PG8_STAGE_A(PG8_SA(0, 0), a2, 0, s0, s1);
            PG8_BAR; PG8_WAIT_L(0); PG8_MMA(1, 0, At, B0); PG8_BAR; PG8_SCHED;
            PG8_STAGE(PG8_SB(0, 1), b2 + hstep, voffB);
            PG8_WAIT_V(6); PG8_BAR; PG8_MMA(1, 1, At, B1); PG8_BAR;
            PG8_LDB(B0, 1, 0); PG8_SCHED; PG8_LDA(At, 1, 0); PG8_STAGE_A(PG8_SA(0, 1), a2, 1, s0, s1);
            PG8_WAIT_L(8); PG8_BAR; PG8_WAIT_L(0); PG8_MMA(0, 0, At, B0); PG8_BAR; PG8_SCHED;
            PG8_LDB(B1, 1, 1); PG8_STAGE(PG8_SB(1, 0), b3, voffB);
            PG8_BAR; PG8_WAIT_L(0); PG8_MMA(0, 1, At, B1); PG8_BAR;
            PG8_LDA(At, 1, 1); PG8_STAGE_A(PG8_SA(1, 0), a3, 0, s0, s1);
            PG8_BAR; PG8_WAIT_L(0); PG8_MMA(1, 0, At, B0); PG8_BAR; PG8_SCHED;
            PG8_STAGE(PG8_SB(1, 1), b3 + hstep, voffB);
            PG8_WAIT_V(6); PG8_BAR; PG8_MMA(1, 1, At, B1); PG8_BAR;
        }
        if constexpr (Epi::FP8) asm volatile("s_nop 15\n\ts_nop 15" ::: "memory");
        E(acc, cur, wr, wc, fr, fq); S.done(cur);
        if (!has_next) break;
#pragma unroll
        for (int a = 0; a < 2; ++a)
#pragma unroll
            for (int b = 0; b < 2; ++b)
#pragma unroll
                for (int m = 0; m < 4; ++m)
#pragma unroll
                    for (int n = 0; n < 2; ++n) acc[a][b][m][n] = (f32x4){0.f, 0.f, 0.f, 0.f};
        cur = nxt; cA = nA; cB = nB; ++ui;
        if constexpr (GA) { vgC0[0] = vgN0[0]; vgC0[1] = vgN0[1]; vgC1[0] = vgN1[0]; vgC1[1] = vgN1[1]; }
    }
    PG8_WAIT_V(0);
    if (wr == 0) PG8_BAR;
    PG8_BAR;
#undef PG8_SA
#undef PG8_SB
#undef PG8_STAGE
#undef PG8_STAGE_A
#undef PG8_GOFF
#undef PG8_LDA
#undef PG8_LDB
#undef PG8_MMA
#undef PG8_WAIT_V
#undef PG8_WAIT_L
#undef PG8_BAR
#undef PG8_SCHED
}
}

struct Params {
    const float *x, *w_in, *ret_nw, *hg_nw, *lb_logits, *w_out, *nmix_w, *nmoe_w, *w_router, *b_router, *w1, *b1, *w2, *b2, *nfin_w;
    float* out;
    bf16_t *hn8, *w_in_t8, *gz; bf16_t *w_in_t, *w_out_t, *w1t, *w2t, *hn, *z, *merged, *hn2, *xg, *hid, *y;
    bf16_t *o_r, *o_h, *h2b; float *h2, *cosT, *sinT, *b1p, *tk_g, *row_gate, *e63;
    bf16_t* k2t; bf16_t* dz; bf16_t *pr, *ph, *kt, *wr_hi, *wr_lo;
    void* pad1;
    int *gcnt, *tk_e, *tk_rank, *pos, *whist;
    float* diag;
    unsigned* bar;
    long long lo_hi;
};

__device__ __forceinline__ float bf2f(unsigned short b) { return __uint_as_float(((unsigned)b) << 16); }
typedef __bf16 bf16v2_t __attribute__((ext_vector_type(2)));
typedef float f32x2_t __attribute__((ext_vector_type(2)));
__device__ __forceinline__ unsigned cvt2(float lo, float hi) { const bf16v2_t r = __builtin_convertvector((f32x2_t){lo, hi}, bf16v2_t); return __builtin_bit_cast(unsigned, r); }
__device__ __forceinline__ unsigned short f2bf(float f) { return (unsigned short)(cvt2(f, 0.f) & 0xffffu); }
__device__ __forceinline__ unsigned cvt4_fp8(float a, float b, float c, float d) {
    a = __builtin_amdgcn_fmed3f(a, -448.f, 448.f); b = __builtin_amdgcn_fmed3f(b, -448.f, 448.f); c = __builtin_amdgcn_fmed3f(c, -448.f, 448.f); d = __builtin_amdgcn_fmed3f(d, -448.f, 448.f);
    int w = 0; w = __builtin_amdgcn_cvt_pk_fp8_f32(a, b, w, false); w = __builtin_amdgcn_cvt_pk_fp8_f32(c, d, w, true); return (unsigned)w;
}
__device__ __forceinline__ float fp8_to_f32(unsigned b) {
    const unsigned sg = (b >> 7) & 1u, ex = (b >> 3) & 15u, mn = b & 7u;
    float v = (ex == 0u) ? (float)mn * 0.001953125f : (1.0f + (float)mn * 0.125f) * exp2f((float)ex - 7.0f);
    return sg ? -v : v;
}
template <int MAP> __host__ __device__ __forceinline__ int p1_tile(int c) { return MAP == 1 ? (c < 24 ? c : c + 8) : MAP == 2 ? (c < 8 ? 24 + c : 48 + c) : c; }
template <int CMAP> __host__ __device__ __forceinline__ int p1_src_col(int ct, int c) {
    if (CMAP == 2) { const int t = ct & 15, base = (ct < 16) ? (c < 128 ? 6144 : 16384) : (c < 128 ? 14336 : 18432); return base + 128 * t + (c & 127); }
    return p1_tile<CMAP>(ct) * 256 + c;
}
__device__ __forceinline__ float wave_sum(float v) {
#pragma unroll
    for (int o = 32; o >= 1; o >>= 1) v += __shfl_xor(v, o);
    return v;
}
__device__ __forceinline__ float sigmoidf_(float x) { return __builtin_amdgcn_rcpf(1.0f + __expf(-x)); }
__device__ __forceinline__ float ex2_(float x) { return __builtin_amdgcn_exp2f(x); }
__device__ __forceinline__ float lg2_(float x) { return __builtin_amdgcn_logf(x); }
__device__ __forceinline__ f32x4 mma16(bf16x8 a, bf16x8 b, f32x4 c) { return __builtin_amdgcn_mfma_f32_16x16x32_bf16(a, b, c, 0, 0, 0); }
__device__ __forceinline__ bf16x8 ldfrag(const LAS bf16_t* base, int ld, int r0, int k0, int lane) {
    return *(const LAS bf16x8*)(base + (r0 + (lane & 15)) * ld + k0 + (lane >> 4) * 8);
}

template <int MODE>
__device__ __forceinline__ void tr_tile8(const float* src, int ldsrc, unsigned char* dst, int lddst, int k0, int c0, LAS float* tl, float scale) {
    const int t = threadIdx.x;
    {
        const int c = t & 63, r0 = t >> 6;
#pragma unroll
        for (int i = 0; i < 8; ++i) tl[(r0 + 8 * i) * 65 + c] = src[(size_t)(k0 + r0 + 8 * i) * ldsrc + c0 + c];
    }
    __syncthreads();
    {
        const int cl = t >> 3, ko = (t & 7) * 8;
        float v[8];
#pragma unroll
        for (int j = 0; j < 8; ++j) v[j] = tl[(ko + j) * 65 + cl] * scale;
        const int col = c0 + cl;
        int drow = col;
        if (MODE == 1) { const int j = col >> 1, lin = col & 1; drow = (j >> 7) * 256 + lin * 128 + (j & 127); }
        u32x2 w; w.x = cvt4_fp8(v[0], v[1], v[2], v[3]); w.y = cvt4_fp8(v[4], v[5], v[6], v[7]);
        *(u32x2*)(dst + (size_t)drow * lddst + k0 + ko) = w;
    }
    __syncthreads();
}
template <int MODE>
__device__ __forceinline__ void tr_tile(const float* src, int ldsrc, bf16_t* dst, int lddst, int k0, int c0, LAS float* tl) {
    const int t = threadIdx.x;
    {
        const int c = t & 63, r0 = t >> 6;
#pragma unroll
        for (int i = 0; i < 8; ++i) tl[(r0 + 8 * i) * 65 + c] = src[(size_t)(k0 + r0 + 8 * i) * ldsrc + c0 + c];
    }
    __syncthreads();
    {
        const int cl = t >> 3, ko = (t & 7) * 8;
        float v[8];
#pragma unroll
        for (int j = 0; j < 8; ++j) v[j] = tl[(ko + j) * 65 + cl];
        const int col = c0 + cl;
        int drow = col;
        if (MODE == 1) { const int j = col >> 1, lin = col & 1; drow = (j >> 7) * 256 + lin * 128 + (j & 127); }
        u32x4 w; w.x = cvt2(v[0], v[1]); w.y = cvt2(v[2], v[3]); w.z = cvt2(v[4], v[5]); w.w = cvt2(v[6], v[7]);
        *(u32x4*)(dst + (size_t)drow * lddst + k0 + ko) = w;
    }
    __syncthreads();
}


template <int MODE, bool F8, int CMAP = 0>
__device__ __forceinline__ void convert_tensor(const float* src, int ldsrc, void* dst, int lddst, int nKt, int nCt, int nE, size_t srcE, size_t dstE, LAS float* tl, int bid, int nb, float scale) {
    const int tid = threadIdx.x, r0 = tid >> 6, c4 = (tid & 63) * 4, col = tid & 255, kh = tid >> 8;
    const int per = nKt * nCt, total = nE * per;
    f32x4 cur[8], nxt[8];
    int t = bid;
#define CT_LOAD(dstv, tt) do { const int _e = (tt) / per, _r = (tt) % per, _kt = _r / nCt, _ct = _r % nCt; \
        const float* _sp = src + (size_t)_e * srcE + (size_t)(_kt * 64 + r0) * ldsrc + p1_src_col<CMAP>(_ct, c4); \
        _Pragma("unroll") for (int i = 0; i < 8; ++i) dstv[i] = *(const f32x4*)(_sp + (size_t)(8 * i) * ldsrc); } while (0)
    if (t < total) CT_LOAD(cur, t);
    for (; t < total; t += nb) {
        const int tn = (t + nb < total) ? t + nb : t;
        CT_LOAD(nxt, tn);
        __builtin_amdgcn_sched_barrier(0);
#pragma unroll
        for (int i = 0; i < 8; ++i) *(LAS f32x4*)(tl + (r0 + 8 * i) * 260 + c4) = cur[i];
        __syncthreads();
        {
            const int e = t / per, r = t % per, kt = r / nCt, ct = r % nCt;
            const int gcol = ct * 256 + col;
            int drow = gcol;
            if (MODE == 1) { const int j = gcol >> 1, lin = gcol & 1; drow = (j >> 7) * 256 + lin * 128 + (j & 127); }
            float v[32];
#pragma unroll
            for (int j = 0; j < 32; ++j) v[j] = tl[(kh * 32 + j) * 260 + col] * scale;
            if (F8) {
                unsigned char* dp = (unsigned char*)dst + (size_t)e * dstE + (size_t)drow * lddst + kt * 64 + kh * 32;
                u32x4 w0, w1;
                w0.x = cvt4_fp8(v[0], v[1], v[2], v[3]); w0.y = cvt4_fp8(v[4], v[5], v[6], v[7]); w0.z = cvt4_fp8(v[8], v[9], v[10], v[11]); w0.w = cvt4_fp8(v[12], v[13], v[14], v[15]);
                w1.x = cvt4_fp8(v[16], v[17], v[18], v[19]); w1.y = cvt4_fp8(v[20], v[21], v[22], v[23]); w1.z = cvt4_fp8(v[24], v[25], v[26], v[27]); w1.w = cvt4_fp8(v[28], v[29], v[30], v[31]);
                *(u32x4*)(dp) = w0; *(u32x4*)(dp + 16) = w1;
            } else {
                bf16_t* dp = (bf16_t*)dst + (size_t)e * dstE + (size_t)drow * lddst + kt * 64 + kh * 32;
#pragma unroll
                for (int q = 0; q < 4; ++q) { u32x4 w; w.x = cvt2(v[8 * q], v[8 * q + 1]); w.y = cvt2(v[8 * q + 2], v[8 * q + 3]); w.z = cvt2(v[8 * q + 4], v[8 * q + 5]); w.w = cvt2(v[8 * q + 6], v[8 * q + 7]); *(u32x4*)(dp + 8 * q) = w; }
            }
        }
        __syncthreads();
        __builtin_amdgcn_sched_barrier(0);
#pragma unroll
        for (int i = 0; i < 8; ++i) cur[i] = nxt[i];
    }
#undef CT_LOAD
}

__device__ __forceinline__ void rms_rows_to_bf16(const float* src, const float* w, bf16_t* dst, int bid, int nb) {
    const int lane = threadIdx.x & 63, wid = threadIdx.x >> 6;
    for (int row = bid * 8 + wid; row < NT; row += nb * 8) {
        const f32x4* xr = (const f32x4*)(src + (size_t)row * DM);
        f32x4 v[8]; float ss = 0.f;
#pragma unroll
        for (int i = 0; i < 8; ++i) { v[i] = xr[i * 64 + lane]; ss += v[i][0] * v[i][0] + v[i][1] * v[i][1] + v[i][2] * v[i][2] + v[i][3] * v[i][3]; }
        ss = wave_sum(ss);
        const float rstd = rsqrtf(ss * (1.0f / DM) + 1e-6f);
#pragma unroll
        for (int i = 0; i < 8; ++i) {
            const f32x4 wv = ((const f32x4*)w)[i * 64 + lane];
            u32x2 o; o.x = cvt2(v[i][0] * rstd * wv[0], v[i][1] * rstd * wv[1]); o.y = cvt2(v[i][2] * rstd * wv[2], v[i][3] * rstd * wv[3]);
            *(u32x2*)(dst + (size_t)row * DM + (i * 64 + lane) * 4) = o;
        }
    }
}

__device__ __forceinline__ void rms_rows_to_both(const float* src, const float* w, bf16_t* dst, unsigned char* dst8, int bid, int nb) {
    const int lane = threadIdx.x & 63, wid = threadIdx.x >> 6;
    for (int row = bid * 8 + wid; row < NT; row += nb * 8) {
        const f32x4* xr = (const f32x4*)(src + (size_t)row * DM);
        f32x4 v[8]; float ss = 0.f;
#pragma unroll
        for (int i = 0; i < 8; ++i) { v[i] = xr[i * 64 + lane]; ss += v[i][0] * v[i][0] + v[i][1] * v[i][1] + v[i][2] * v[i][2] + v[i][3] * v[i][3]; }
        ss = wave_sum(ss);
        const float rstd = rsqrtf(ss * (1.0f / DM) + 1e-6f);
#pragma unroll
        for (int i = 0; i < 8; ++i) {
            const f32x4 wv = ((const f32x4*)w)[i * 64 + lane];
            const f32x4 o = v[i] * rstd * wv;
            u32x2 ob; ob.x = cvt2(o[0], o[1]); ob.y = cvt2(o[2], o[3]);
            *(u32x2*)(dst + (size_t)row * DM + (i * 64 + lane) * 4) = ob;
            *(unsigned*)(dst8 + (size_t)row * DM + (i * 64 + lane) * 4) = cvt4_fp8(o[0] * X_SCALE, o[1] * X_SCALE, o[2] * X_SCALE, o[3] * X_SCALE);
        }
    }
}
__device__ __forceinline__ void rms_rows_to_fp8(const float* src, const float* w, unsigned char* dst, int bid, int nb) {
    const int lane = threadIdx.x & 63, wid = threadIdx.x >> 6;
    for (int row = bid * 8 + wid; row < NT; row += nb * 8) {
        const f32x4* xr = (const f32x4*)(src + (size_t)row * DM);
        f32x4 v[8]; float ss = 0.f;
#pragma unroll
        for (int i = 0; i < 8; ++i) { v[i] = xr[i * 64 + lane]; ss += v[i][0] * v[i][0] + v[i][1] * v[i][1] + v[i][2] * v[i][2] + v[i][3] * v[i][3]; }
        ss = wave_sum(ss);
        const float rstd = rsqrtf(ss * (1.0f / DM) + 1e-6f) * X_SCALE;
#pragma unroll
        for (int i = 0; i < 8; ++i) {
            const f32x4 wv = ((const f32x4*)w)[i * 64 + lane];
            *(unsigned*)(dst + (size_t)row * DM + (i * 64 + lane) * 4) = cvt4_fp8(v[i][0] * rstd * wv[0], v[i][1] * rstd * wv[1], v[i][2] * rstd * wv[2], v[i][3] * rstd * wv[3]);
        }
    }
}
__device__ __forceinline__ void p0_prologue(const Params& p, LAS unsigned char* lds, int bid, int nb) {
    LAS float* tl = (LAS float*)lds;
    const int tid = threadIdx.x;
    for (int i = bid * NTHREADS + tid; i < SEQ * 128; i += nb * NTHREADS) {
        const int s = i >> 7, pr = i & 127;
        const float inv = exp2f(-(float)pr * (13.287712379549449f / 127.0f));
        const double rev = (double)s * (double)inv * 0.15915494309189535;
        const float fr = (float)(rev - floor(rev));
        p.cosT[i] = __builtin_amdgcn_cosf(fr); p.sinT[i] = __builtin_amdgcn_sinf(fr);
    }
    for (int i = bid * NTHREADS + tid; i < NE * DM; i += nb * NTHREADS) {
        const int e = i >> 11, k = i & 2047; const float v = p.w_router[(size_t)k * NE + e];
        const bf16_t hi = f2bf(v); p.wr_hi[i] = hi; p.wr_lo[i] = f2bf(v - bf2f(hi));
    }
    for (int i = bid * NTHREADS + tid; i < NE * 4096; i += nb * NTHREADS) {
        const int e = i >> 12, np = i & 4095, pn = np >> 8, cl = np & 255, j = pn * 128 + (cl & 127);
        p.b1p[i] = p.b1[e * 4096 + 2 * j + (cl >> 7)];
    }
#if P1_MIX
    rms_rows_to_both(p.x, p.nmix_w, p.hn, (unsigned char*)p.hn8, bid, nb);
#else
    if (P1_FP8) rms_rows_to_fp8(p.x, p.nmix_w, (unsigned char*)p.hn, bid, nb); else rms_rows_to_bf16(p.x, p.nmix_w, p.hn, bid, nb);
#endif
    __syncthreads();
#if P1_MIX
    convert_tensor<0, false, 1>(p.w_in, NZ, p.w_in_t, DM, 32, 48, 1, 0, 0, tl, bid, nb, 1.0f);
    convert_tensor<0, true, 2>(p.w_in, NZ, p.w_in_t8, DM, 32, 32, 1, 0, 0, tl, bid, nb, W_SCALE);
#else
    if (P1_FP8) convert_tensor<0, true>(p.w_in, NZ, p.w_in_t, DM, 32, NZ / 256, 1, 0, 0, tl, bid, nb, W_SCALE);
    else convert_tensor<0, false>(p.w_in, NZ, p.w_in_t, DM, 32, NZ / 256, 1, 0, 0, tl, bid, nb, 1.0f);
#endif
    convert_tensor<0, false>(p.w_out, DM, p.w_out_t, DM, 32, DM / 256, 1, 0, 0, tl, bid, nb, 1.0f);
    if (nb != 256) convert_tensor<1, true>(p.w1, 4096, p.w1t, DM, 32, 16, NE, (size_t)DM * 4096, (size_t)4096 * DM, tl, bid, nb, W_SCALE);
    if (nb == 256) convert_tensor<0, true>(p.w2 + (size_t)16 * DFF * DM, DM, (unsigned char*)p.w2t + (size_t)16 * DM * DFF, DFF, 32, 8, 16, (size_t)DFF * DM, (size_t)DM * DFF, tl, bid, nb, W_SCALE);
    else convert_tensor<0, true>(p.w2, DM, p.w2t, DFF, 32, 8, NE, (size_t)DFF * DM, (size_t)DM * DFF, tl, bid, nb, W_SCALE);
}

template <bool F8, int MAP>
struct EpiZT {
    static constexpr bool PERM = true, AFTER_DRAIN = false, FP8 = F8;
    bf16_t* Z; const float* cosT; const float* sinT;
    __device__ __forceinline__ void operator()(const f32x4 (&acc)[2][2][4][2], const pg8::Unit& u, int wr, int wc, int fr, int fq) const {
        const int pn = p1_tile<MAP>(u.pn);
        const int row0 = u.pm * 256 + wr * 64 + fr, pc = wc * 32 + 8 * fq, col0 = pn * 256 + pc;
        const bool rot = pn < 16; const float sc = (pn >= 8 && pn < 16) ? 0.0625f : 1.0f;
#pragma unroll
        for (int ai = 0; ai < 2; ++ai)
#pragma unroll
            for (int m = 0; m < 4; ++m) {
                const int row = row0 + ai * 128 + m * 16;
                constexpr float dqz = FP8 ? 1.0f / (W_SCALE * X_SCALE) : 1.0f;
                f32x4 a0 = acc[ai][0][m][0] * dqz, a1 = acc[ai][0][m][1] * dqz, b0 = acc[ai][1][m][0] * dqz, b1 = acc[ai][1][m][1] * dqz;
                if (rot) {
                    const int s = row & (SEQ - 1);
                    const f32x4 c0 = *(const f32x4*)(cosT + s * 128 + pc), c1 = *(const f32x4*)(cosT + s * 128 + pc + 4);
                    const f32x4 s0 = *(const f32x4*)(sinT + s * 128 + pc), s1 = *(const f32x4*)(sinT + s * 128 + pc + 4);
                    const f32x4 na0 = (a0 * c0 - b0 * s0) * sc, na1 = (a1 * c1 - b1 * s1) * sc;
                    const f32x4 nb0 = (b0 * c0 + a0 * s0) * sc, nb1 = (b1 * c1 + a1 * s1) * sc;
                    a0 = na0; a1 = na1; b0 = nb0; b1 = nb1;
                }
                bf16_t* rowp = Z + (size_t)row * NZ + col0;
                u32x4 w; w.x = cvt2(a0[0], a0[1]); w.y = cvt2(a0[2], a0[3]); w.z = cvt2(a1[0], a1[1]); w.w = cvt2(a1[2], a1[3]);
                *(u32x4*)(rowp) = w;
                u32x4 v; v.x = cvt2(b0[0], b0[1]); v.y = cvt2(b0[2], b0[3]); v.z = cvt2(b1[0], b1[1]); v.w = cvt2(b1[2], b1[3]);
                *(u32x4*)(rowp + 128) = v;
            }
    }
};
struct EpiGate {
    static constexpr bool PERM = true, AFTER_DRAIN = false, FP8 = true;
    bf16_t* G;
    __device__ __forceinline__ void operator()(const f32x4 (&acc)[2][2][4][2], const pg8::Unit& u, int wr, int wc, int fr, int fq) const {
        const int row0 = u.pm * 256 + wr * 64 + fr, col0 = u.pn * 128 + wc * 32 + 8 * fq;
        typedef float f2 __attribute__((ext_vector_type(2)));
        float dqv = 1.0f / (W_SCALE * X_SCALE), ndv = -1.4426950408889634f / (W_SCALE * X_SCALE); asm volatile("" : "+s"(dqv), "+s"(ndv));
        const f2 dq2 = (f2){dqv, dqv}, nd2 = (f2){ndv, ndv}, one2 = (f2){1.0f, 1.0f};
#pragma unroll
        for (int ai = 0; ai < 2; ++ai)
#pragma unroll
            for (int m = 0; m < 4; ++m) {
                const int row = row0 + ai * 128 + m * 16;
                float o[8];
#pragma unroll
                for (int n = 0; n < 2; ++n)
#pragma unroll
                    for (int i = 0; i < 4; i += 2) {
                        const f2 a = (f2){acc[ai][0][m][n][i], acc[ai][0][m][n][i + 1]}, b = (f2){acc[ai][1][m][n][i], acc[ai][1][m][n][i + 1]};
                        const f2 ta = a * nd2, tb = b * nd2;
                        f2 t; t.x = ex2_(ta.x); t.y = ex2_(ta.y); t = t + one2;
                        f2 eb; eb.x = ex2_(tb.x); eb.y = ex2_(tb.y);
                        const f2 den = eb * t + t;
                        f2 r; r.x = __builtin_amdgcn_rcpf(den.x); r.y = __builtin_amdgcn_rcpf(den.y);
                        const f2 g = (a * dq2) * r; o[4 * n + i] = g.x; o[4 * n + i + 1] = g.y; }
                u32x4 w; w.x = cvt2(o[0], o[1]); w.y = cvt2(o[2], o[3]); w.z = cvt2(o[4], o[5]); w.w = cvt2(o[6], o[7]);
                *(u32x4*)(G + (size_t)row * 4096 + col0) = w;
            }
    }
};
struct EpiRes {
    static constexpr bool PERM = true, AFTER_DRAIN = false, FP8 = false;
    bf16_t* C; const float* R;
    __device__ __forceinline__ void operator()(const f32x4 (&acc)[2][2][4][2], const pg8::Unit& u, int wr, int wc, int fr, int fq) const {
        const int row0 = u.pm * 256 + wr * 64 + fr, col0 = u.pn * 256 + wc * 32 + 8 * fq;
#pragma unroll
        for (int ai = 0; ai < 2; ++ai)
#pragma unroll
            for (int m = 0; m < 4; ++m) {
                const size_t ro = (size_t)(row0 + ai * 128 + m * 16) * DM + col0;
#pragma unroll
                for (int bj = 0; bj < 2; ++bj) {
                    const f32x4 r0 = *(const f32x4*)(R + ro + bj * 128), r1 = *(const f32x4*)(R + ro + bj * 128 + 4);
                    const f32x4 v0 = acc[ai][bj][m][0] + r0, v1 = acc[ai][bj][m][1] + r1;
                    u32x4 w; w.x = cvt2(v0[0], v0[1]); w.y = cvt2(v0[2], v0[3]); w.z = cvt2(v1[0], v1[1]); w.w = cvt2(v1[2], v1[3]);
                    *(u32x4*)(C + ro + bj * 128) = w;
                }
            }
    }
};
struct EpiSwiglu {
    static constexpr bool PERM = true, AFTER_DRAIN = false, FP8 = true;
    unsigned char* H; const float* b1p;
    typedef float f2 __attribute__((ext_vector_type(2)));
    static __device__ __forceinline__ f2 act2(f2 ag, f2 al, f2 bg, f2 bl, f2 dq2) {
        const f2 g = ag * dq2 + bg, l = al * dq2 + bl;
        f2 xg, xl; xg.x = fminf(g.x, 7.0f); xg.y = fminf(g.y, 7.0f);
        xl.x = __builtin_amdgcn_fmed3f(l.x, -7.0f, 7.0f); xl.y = __builtin_amdgcn_fmed3f(l.y, -7.0f, 7.0f);
        const f2 t = xg * (f2){-1.702f * 1.4426950408889634f, -1.702f * 1.4426950408889634f};
        f2 d; d.x = ex2_(t.x); d.y = ex2_(t.y); d = d + (f2){1.0f, 1.0f};
        f2 r; r.x = __builtin_amdgcn_rcpf(d.x); r.y = __builtin_amdgcn_rcpf(d.y);
        return (xg * r) * (xl * (f2){H_SCALE, H_SCALE} + (f2){H_SCALE, H_SCALE});
    }
    __device__ __forceinline__ void operator()(const f32x4 (&acc)[2][2][4][2], const pg8::Unit& u, int wr, int wc, int fr, int fq) const {
        const int e = u.pn >> 4, pnl = u.pn & 15, pc = wc * 32 + 8 * fq;
        const float* bp = b1p + e * 4096 + pnl * 256 + pc;
        const f32x4 bg0 = *(const f32x4*)(bp), bg1 = *(const f32x4*)(bp + 4), bl0 = *(const f32x4*)(bp + 128), bl1 = *(const f32x4*)(bp + 132);
        const int row0 = u.pm * 256 + wr * 64 + fr;
        float dqv = 1.0f / (W_SCALE * X_SCALE); asm volatile("" : "+s"(dqv));
        const f2 dq2 = (f2){dqv, dqv};
#pragma unroll
        for (int ai = 0; ai < 2; ++ai)
#pragma unroll
            for (int m = 0; m < 4; ++m) {
                const int row = row0 + ai * 128 + m * 16;
                const f32x4 ag0 = acc[ai][0][m][0], ag1 = acc[ai][0][m][1], al0 = acc[ai][1][m][0], al1 = acc[ai][1][m][1];
                const f2 o0 = act2(ag0.xy, al0.xy, bg0.xy, bl0.xy, dq2), o1 = act2(ag0.zw, al0.zw, bg0.zw, bl0.zw, dq2);
                const f2 o2 = act2(ag1.xy, al1.xy, bg1.xy, bl1.xy, dq2), o3 = act2(ag1.zw, al1.zw, bg1.zw, bl1.zw, dq2);
                int w0 = 0, w1 = 0;
                w0 = __builtin_amdgcn_cvt_pk_fp8_f32(o0.x, o0.y, w0, false); w0 = __builtin_amdgcn_cvt_pk_fp8_f32(o1.x, o1.y, w0, true);
                w1 = __builtin_amdgcn_cvt_pk_fp8_f32(o2.x, o2.y, w1, false); w1 = __builtin_amdgcn_cvt_pk_fp8_f32(o3.x, o3.y, w1, true);
                u32x2 w; w.x = (unsigned)w0; w.y = (unsigned)w1;
                *(u32x2*)(H + (size_t)row * DFF + pnl * 128 + pc) = w;
            }
    }
};
struct EpiY {
    static constexpr bool PERM = true, AFTER_DRAIN = false, FP8 = true;
    bf16_t* Y; const float* b2; const float* gate;
    __device__ __forceinline__ void operator()(const f32x4 (&acc)[2][2][4][2], const pg8::Unit& u, int wr, int wc, int fr, int fq) const {
        const int e = u.pn >> 3, pnl = u.pn & 7, col0 = pnl * 256 + wc * 32 + 8 * fq;
        const float* bp = b2 + e * DM + col0;
        f32x4 bv[2][2];
#pragma unroll
        for (int bj = 0; bj < 2; ++bj)
#pragma unroll
            for (int n = 0; n < 2; ++n) bv[bj][n] = *(const f32x4*)(bp + bj * 128 + 4 * n);
        const int row0 = u.pm * 256 + wr * 64 + fr;
        float dqv = 1.0f / (W_SCALE * H_SCALE); asm volatile("" : "+s"(dqv));
#pragma unroll
        for (int ai = 0; ai < 2; ++ai)
#pragma unroll
            for (int m = 0; m < 4; ++m) {
                const int row = row0 + ai * 128 + m * 16;
                const float gt = gate[row];
#pragma unroll
                for (int bj = 0; bj < 2; ++bj) {
                    const f32x4 v0 = (acc[ai][bj][m][0] * dqv + bv[bj][0]) * (gt * Y_SCALE), v1 = (acc[ai][bj][m][1] * dqv + bv[bj][1]) * (gt * Y_SCALE);
                    u32x2 w; w.x = cvt4_fp8(v0[0], v0[1], v0[2], v0[3]); w.y = cvt4_fp8(v1[0], v1[1], v1[2], v1[3]);
                    *(u32x2*)((unsigned char*)Y + (size_t)row * DM + col0 + bj * 128) = w;
                }
            }
    }
};

struct MoeOrder {
    int nM, nN, nwg, G, c; const LAS int* tile_e;
    __device__ void init(int nM_, int nN_, int G_, int c_, const LAS int* te) { nM = nM_; nN = nN_; nwg = nM * nN; G = G_; c = c_; tile_e = te; }
    __device__ bool next(int i, pg8::Unit& u) const {
        const long L = (long)i * G + c; if (L >= nwg) return false;
        int wgid = (int)L; { const int q = nwg / pg8::NXCD, r = nwg % pg8::NXCD, xcd = wgid % pg8::NXCD, off = wgid / pg8::NXCD; wgid = (xcd < r ? xcd * (q + 1) : r * (q + 1) + (xcd - r) * q) + off; }
        const int nig = pg8::WGM * nN, gid = wgid / nig, fm = gid * pg8::WGM, gsz = (nM - fm) < pg8::WGM ? (nM - fm) : pg8::WGM;
        u.pm = fm + ((wgid % nig) % gsz); const int pnl = (wgid % nig) / gsz; u.pn = __builtin_amdgcn_readfirstlane(tile_e[u.pm]) * nN + pnl; return true;
    }
    __device__ __forceinline__ void a_ready(const pg8::Unit&) const {}
    __device__ __forceinline__ void done(const pg8::Unit&) const {}
    static constexpr bool GATHER = false; const int* rowtok;
};
struct MoeGather : MoeOrder { static constexpr bool GATHER = true; };

__device__ __forceinline__ void build_tiles(const Params& p, LAS int* tb) {
    if (threadIdx.x < NE) tb[128 + 256 + threadIdx.x] = p.gcnt[threadIdx.x];
    __syncthreads();
    if (threadIdx.x == 0) {
        int t = 0;
        for (int e = 0; e < NE; ++e) {
            const int c = tb[128 + 256 + e], nt = (c + 255) >> 8;
            tb[1 + e] = t * 256;
            for (int k = 0; k < nt; ++k) tb[64 + t + k] = e;
            t += nt;
        }
        tb[0] = t;
    }
    __syncthreads();
}

__device__ __forceinline__ void ret_prepass(const Params& p, LAS unsigned char* lds, int bid, int nb) {
    const int tid = threadIdx.x, lane = tid & 63, wid = tid >> 6, quad = lane >> 4, l15 = lane & 15;
    LAS bf16_t* Qs = (LAS bf16_t*)lds;
    LAS bf16_t* Ks = Qs + 64 * 264;
    LAS bf16_t* Ps = Ks + 64 * 264;
    u32x4 rq[4], rk[4];
#define RP_ISSUE(u_) do { const int _h = (u_) & 7, _n = ((u_) >> 3) & 63, _b = (u_) >> 9; \
        _Pragma("unroll") for (int i = 0; i < 4; ++i) { const int piece = tid + NTHREADS * i, row = piece >> 5, cc = (piece & 31) * 8; \
            const bf16_t* rp = p.z + (size_t)(_b * SEQ + _n * 64 + row) * NZ + _h * 256 + cc; rq[i] = *(const u32x4*)(rp); rk[i] = *(const u32x4*)(rp + 2048); } } while (0)
    int u = bid;
    RP_ISSUE(u < 2048 ? u : 2047);
    asm volatile("" :: "v"(rq[3]), "v"(rk[3]));
    for (; u < 2048; u += nb) {
        const int h = u & 7;
        const float lg2 = log2f(1.0f - exp2f(-5.0f - (float)h));
#pragma unroll
        for (int i = 0; i < 4; ++i) { const int piece = tid + NTHREADS * i, row = piece >> 5, cc = (piece & 31) * 8; *(LAS u32x4*)(Qs + row * 264 + cc) = rq[i]; *(LAS u32x4*)(Ks + row * 264 + cc) = rk[i]; }
        RP_ISSUE(u + nb < 2048 ? u + nb : u);
        __syncthreads();
        {
            const int mi = wid >> 1, nb0 = (wid & 1) * 2;
            f32x4 a0 = (f32x4){0.f, 0.f, 0.f, 0.f}, a1 = a0;
#pragma unroll
            for (int ks = 0; ks < 8; ++ks) {
                const bf16x8 A = ldfrag(Qs, 264, mi * 16, ks * 32, lane);
                a0 = mma16(A, ldfrag(Ks, 264, nb0 * 16, ks * 32, lane), a0); a1 = mma16(A, ldfrag(Ks, 264, nb0 * 16 + 16, ks * 32, lane), a1);
            }
#pragma unroll
            for (int jj = 0; jj < 4; ++jj) {
                const int i = mi * 16 + quad * 4 + jj, j0 = nb0 * 16 + l15, j1 = j0 + 16;
                Ps[i * 72 + j0] = f2bf(a0[jj] * exp2f(fabsf((float)(i - j0)) * lg2));
                Ps[i * 72 + j1] = f2bf(a1[jj] * exp2f(fabsf((float)(i - j1)) * lg2));
            }
        }
        {
#pragma unroll
            for (int i = 0; i < 4; ++i) {
                const int piece = tid + NTHREADS * i, dk = piece & 255, j0 = (piece >> 8) * 8;
                float v[8];
#pragma unroll
                for (int e = 0; e < 8; ++e) v[e] = bf2f(Ks[(j0 + e) * 264 + dk]) * exp2f((float)(63 - j0 - e) * lg2);
                u32x4 w; w.x = cvt2(v[0], v[1]); w.y = cvt2(v[2], v[3]); w.z = cvt2(v[4], v[5]); w.w = cvt2(v[6], v[7]);
                *(u32x4*)(p.kt + ((size_t)u * 256 + dk) * 64 + j0) = w;
            }
        }
        __syncthreads();
        { const int row = tid >> 3, c8 = (tid & 7) * 8; *(u32x4*)(p.pr + (size_t)u * 4096 + row * 64 + c8) = *(const LAS u32x4*)(Ps + row * 72 + c8); }
    }
#undef RP_ISSUE
}

struct Cv2Tile { const float* src; unsigned char* dst; int c0; };
__device__ __forceinline__ Cv2Tile cv_decode_w2(const Params& p, int s) {
    const int e = s >> 9, r = s & 511, kt = r >> 3, ct = r & 7;
    Cv2Tile t; t.src = p.w2 + (size_t)e * DFF * DM + (size_t)(kt * 32) * DM + ct * 256; t.dst = (unsigned char*)p.w2t + (size_t)e * DM * DFF + kt * 32; t.c0 = ct * 256; return t;
}
#define W2Q_DEC(q_) const int _w = bid + 256 * ((q_) >> 2), _e = _w >> 7, _kt = ((_w >> 3) & 15) * 4 + ((q_) & 3), _ct = _w & 7
#define W2Q_LOAD(cvr, q_) do { W2Q_DEC(q_); const float* _sp = p.w2 + (size_t)_e * DFF * DM + (size_t)(_kt * 32 + (tid >> 6) * 4) * DM + _ct * 256 + (tid & 63) * 4; \
        _Pragma("unroll") for (int i = 0; i < 4; ++i) cvr[i] = *(const f32x4*)(_sp + (size_t)i * DM); } while (0)
#define W2Q_TILE(q_) ((LAS unsigned*)(lds + 48128) + (((q_) >> 2) & 1) * (4 * 2320) + ((q_) & 3) * 2320)
#define W2Q_OUT(q_) do { W2Q_DEC(q_); const int _pc = tid & 7; const LAS unsigned* _tb = (const LAS unsigned*)(lds + 48128) + (((q_) >> 2) & 1) * (4 * 2320) + (_pc >> 1) * 2320 + (_pc & 1) * 4; \
        unsigned char* _db = (unsigned char*)p.w2t + (size_t)_e * DM * DFF + (_kt >> 2) * 128 + _pc * 16; \
        _Pragma("unroll") for (int r = 0; r < 4; ++r) { const int _col = r * 64 + (tid >> 3); const LAS unsigned* _tw = _tb + _col * 9; \
            u32x4 _v; _v.x = _tw[0]; _v.y = _tw[1]; _v.z = _tw[2]; _v.w = _tw[3]; *(u32x4*)(_db + (size_t)(_ct * 256 + _col) * DFF) = _v; } } while (0)
#define W2_LOAD(cvr, s_) do { const Cv2Tile _t = cv_decode_w2(p, (s_)); const float* _sp = _t.src + (size_t)((tid >> 6) * 4) * DM + (tid & 63) * 4; \
        _Pragma("unroll") for (int i = 0; i < 4; ++i) cvr[i] = *(const f32x4*)(_sp + (size_t)i * DM); } while (0)
#define W2_WRITE(cvr, tl_) do { LAS unsigned* _tw = (LAS unsigned*)(tl_); _Pragma("unroll") for (int c = 0; c < 4; ++c) \
        _tw[((tid & 63) * 4 + c) * 9 + (tid >> 6)] = cvt4_fp8(cvr[0][c] * W_SCALE, cvr[1][c] * W_SCALE, cvr[2][c] * W_SCALE, cvr[3][c] * W_SCALE); } while (0)
#define W2_OUT(tl_, s_) do { const Cv2Tile _t = cv_decode_w2(p, (s_)); const int _col = tid & 255, _kq = tid >> 8; const LAS unsigned* _tw = (const LAS unsigned*)(tl_) + _col * 9 + _kq * 4; \
        u32x4 _w; _w.x = _tw[0]; _w.y = _tw[1]; _w.z = _tw[2]; _w.w = _tw[3]; \
        *(u32x4*)(_t.dst + (size_t)(_t.c0 + _col) * DFF + _kq * 16) = _w; } while (0)
template <bool HOST>
__device__ __forceinline__ void hg_prepass(const Params& p, LAS unsigned char* lds, int bid, int nb) {
    const int tid = threadIdx.x, lane = tid & 63, wid = tid >> 6, quad = lane >> 4, l15 = lane & 15, d = tid & 127, g = tid >> 7;
    LAS bf16_t* As = (LAS bf16_t*)lds;
    LAS bf16_t* Bs = As + 64 * 136;
    LAS bf16_t* Ps = Bs + 64 * 136;
    LAS float* cpart = (LAS float*)(Ps + 64 * 72);
    unsigned short rqh[16], rfh[16];
    LAS unsigned char* wt0 = lds + 48128; LAS unsigned char* wt1 = wt0 + 9216;
    f32x4 cvA[4], cvB[4];
#define HP_ISSUE(u_) do { const int _h = (u_) & 15, _n = ((u_) >> 4) & 63, _b = (u_) >> 10; const bf16_t* _zq = p.z + (size_t)(_b * SEQ + _n * 64 + 16 * g) * NZ + 8192 + _h * 128 + d; \
        _Pragma("unroll") for (int r = 0; r < 16; ++r) { rqh[r] = _zq[(size_t)r * NZ]; rfh[r] = _zq[(size_t)r * NZ + 2048]; } } while (0)
    int it = 0, u = bid;
    HP_ISSUE(u < 4096 ? u : 4095);
    if constexpr (HOST) { W2Q_LOAD(cvA, 0); W2Q_LOAD(cvB, 1); asm volatile("" :: "v"(cvA[3]), "v"(cvB[3])); }
    asm volatile("" :: "v"(rqh[15]), "v"(rfh[15]));
    for (; u < 4096; u += nb, ++it) {
        const int h = u & 15, n = (u >> 4) & 63, b = u >> 10;
        const float lbv = 1.0f / (1.0f + __expf(p.lb_logits[DM + h * 128 + d] - p.lb_logits[h * 128 + d]));
        const float om = 1.0f - lbv;
        bf16_t* zq = p.z + (size_t)(b * SEQ + n * 64 + 16 * g) * NZ + 8192 + h * 128 + d;
#if DIAG == 1 || DIAG == 2
        { bf16_t* dq_ = p.dz + (size_t)(b * SEQ + n * 64 + 16 * g) * 4096 + h * 128 + d;
#pragma unroll
          for (int r = 0; r < 16; ++r) { dq_[(size_t)r * 4096] = rqh[r]; dq_[(size_t)r * 4096 + 2048] = rfh[r]; } }
#endif
        float cl[16], kk[16], qv[16]; float c = 0.f;
#pragma unroll
        for (int r = 0; r < 16; ++r) { const float sg = __builtin_amdgcn_rcpf(1.0f + ex2_(bf2f(rfh[r]) * -1.4426950408889634f)); const float f = lbv + om * sg; c += lg2_(f); cl[r] = c; kk[r] = om * (1.0f - sg); qv[r] = bf2f(rqh[r]); }
        HP_ISSUE(u + nb < 4096 ? u + nb : u);
        LAS float* cp = cpart + (it & 1) * 512;
        cp[g * 128 + d] = c;
        if constexpr (HOST) { W2_WRITE(cvA, W2Q_TILE(2 * it)); W2Q_LOAD(cvA, it + 1 < 16 ? 2 * it + 2 : 2 * it); }
        __syncthreads();
        float off = 0.f, tot = 0.f;
#pragma unroll
        for (int gg = 0; gg < 4; ++gg) { const float v = cp[gg * 128 + d]; tot += v; off += (gg < g) ? v : 0.f; }
        const float etot = ex2_(tot);
        unsigned k2p[8];
#pragma unroll
        for (int r = 0; r < 16; r += 2) {
            float k2v[2];
#pragma unroll
            for (int q = 0; q < 2; ++q) {
                const float cum = off + cl[r + q];
                const float ea = ex2_(cum), bb = kk[r + q] * ex2_(-cum);
                k2v[q] = bb * etot;
                const bf16_t av = f2bf(qv[r + q] * ea * __builtin_amdgcn_rcpf(1.0f + ex2_(qv[r + q] * -1.4426950408889634f)));
                zq[(size_t)(r + q) * NZ] = av;
                As[(16 * g + r + q) * 136 + d] = av; Bs[(16 * g + r + q) * 136 + d] = f2bf(bb);
            }
            k2p[r >> 1] = cvt2(k2v[0], k2v[1]);
        }
        bf16_t* kd = p.k2t + ((size_t)u * 128 + d) * 64 + 16 * g;
        *(u32x4*)(kd) = (u32x4){k2p[0], k2p[1], k2p[2], k2p[3]};
        *(u32x4*)(kd + 8) = (u32x4){k2p[4], k2p[5], k2p[6], k2p[7]};
        p.e63[u * 128 + d] = etot;
        if constexpr (HOST) { W2_WRITE(cvB, W2Q_TILE(2 * it + 1)); W2Q_LOAD(cvB, it + 1 < 16 ? 2 * it + 3 : 2 * it + 1); }
        __syncthreads();
        if (HOST && (it & 1)) W2Q_OUT(2 * it + 1);
        {
            const int mi = wid >> 1, nb0 = (wid & 1) * 2;
            f32x4 a0 = (f32x4){0.f, 0.f, 0.f, 0.f}, a1 = a0;
#pragma unroll
            for (int ks = 0; ks < 4; ++ks) {
                const bf16x8 A = ldfrag(As, 136, mi * 16, ks * 32, lane);
                a0 = mma16(A, ldfrag(Bs, 136, nb0 * 16, ks * 32, lane), a0); a1 = mma16(A, ldfrag(Bs, 136, nb0 * 16 + 16, ks * 32, lane), a1);
            }
#pragma unroll
            for (int jj = 0; jj < 4; ++jj) {
                const int i = mi * 16 + quad * 4 + jj, j0 = nb0 * 16 + l15, j1 = j0 + 16;
                bf16_t* pd = p.ph + (size_t)u * 4096 + i * 64;
                pd[j0] = (i >= j0) ? f2bf(a0[jj]) : (bf16_t)0; pd[j1] = (i >= j1) ? f2bf(a1[jj]) : (bf16_t)0;
            }
        }
    }
#undef HP_ISSUE
}


struct CvTile { const float* src; unsigned char* dst; int c0; };
__device__ __forceinline__ CvTile cv_decode_w1(const Params& p, int s) {
    const int e = s >> 10, r = s & 1023, kt = r >> 4, ct = r & 15;
    CvTile t; t.src = p.w1 + (size_t)e * DM * 4096 + (size_t)(kt * 32) * 4096 + ct * 256; t.dst = (unsigned char*)p.w1t + (size_t)e * 4096 * DM + kt * 32; t.c0 = ct * 256; return t;
}
#define CV_LOAD(s_) do { const CvTile _t = cv_decode_w1(p, (s_)); const float* _sp = _t.src + (size_t)((tid >> 6) * 4) * 4096 + (tid & 63) * 4; \
        _Pragma("unroll") for (int i = 0; i < 4; ++i) cv[i] = *(const f32x4*)(_sp + (size_t)i * 4096); } while (0)
#define CV_WRITE() do { LAS unsigned* _tw = (LAS unsigned*)cvt_; _Pragma("unroll") for (int c = 0; c < 4; ++c) \
        _tw[((tid & 63) * 4 + c) * 9 + (tid >> 6)] = cvt4_fp8(cv[0][c] * W_SCALE, cv[1][c] * W_SCALE, cv[2][c] * W_SCALE, cv[3][c] * W_SCALE); } while (0)
#define CV_OUT(s_) do { const CvTile _t = cv_decode_w1(p, (s_)); const int _col = tid & 255, _kq = tid >> 8, _g = _t.c0 + _col, _j = _g >> 1; \
        const int _drow = (_j >> 7) * 256 + (_g & 1) * 128 + (_j & 127); const LAS unsigned* _tw = (const LAS unsigned*)cvt_ + _col * 9 + _kq * 4; \
        u32x4 _w; _w.x = _tw[0]; _w.y = _tw[1]; _w.z = _tw[2]; _w.w = _tw[3]; \
        *(u32x4*)(_t.dst + (size_t)_drow * DM + _kq * 16) = _w; } while (0)

__device__ __forceinline__ void mixer_ret(const Params& p, LAS unsigned char* lds, int unit, int cvbase) {
    const int tid = threadIdx.x, lane = tid & 63, wid = tid >> 6, quad = lane >> 4, l15 = lane & 15;
    const int sl = unit & 7, h = (unit >> 3) & 7, b = unit >> 6;
    LAS bf16_t* Qs = (LAS bf16_t*)lds;
    LAS bf16_t* KTs = Qs + 64 * 264;
    LAS bf16_t* Ps = KTs + 256 * 72;
    LAS bf16_t* Vt = Ps + 64 * 72;
    LAS bf16_t* St = Vt + 32 * 72;
    LAS float* cvt_ = (LAS float*)(lds + 118272);
    f32x4 cv[4];
    const float lg2 = log2f(1.0f - exp2f(-5.0f - (float)h));
    const float g64 = exp2f(64.0f * lg2);
    for (int i = tid; i < 2 * 32 * 264 / 2; i += NTHREADS) ((LAS unsigned*)St)[i] = 0u;
    f32x4 Sacc[2][2];
#pragma unroll
    for (int a = 0; a < 2; ++a)
#pragma unroll
        for (int c = 0; c < 2; ++c) Sacc[a][c] = (f32x4){0.f, 0.f, 0.f, 0.f};
    const bf16_t* zb = p.z + (size_t)(b * SEQ) * NZ;
    const int qcol = h * 256, vcol = 4096 + h * 256 + sl * 32;
    u32x4 rq[4], rk[4], rp, rv = (u32x4){0u, 0u, 0u, 0u};
#define RET_ISSUE(n) do { const size_t un = (size_t)((b * 64 + (n)) * 8 + h); \
        _Pragma("unroll") for (int i = 0; i < 4; ++i) { const int piece = tid + NTHREADS * i; \
            { const int row = piece >> 5, cc = (piece & 31) * 8; rq[i] = *(const u32x4*)(zb + (size_t)((n) * 64 + row) * NZ + qcol + cc); } \
            { const int dk = piece >> 3, jc = (piece & 7) * 8; rk[i] = *(const u32x4*)(p.kt + (un * 256 + dk) * 64 + jc); } } \
        { const int row = tid >> 3, c8 = (tid & 7) * 8; rp = *(const u32x4*)(p.pr + un * 4096 + row * 64 + c8); } \
        if (tid < 256) { const int row = tid >> 2, cc = (tid & 3) * 8; rv = *(const u32x4*)(zb + (size_t)((n) * 64 + row) * NZ + vcol + cc); } } while (0)
    LAS bf16_t* Ot = (LAS bf16_t*)(lds + 127488);
#define RET_OSTORE(nn) do { if (tid < 256) { const int _row = tid >> 2, _sg = tid & 3; \
        *(u32x4*)(p.o_r + (size_t)(b * SEQ + (nn) * 64 + _row) * DM + h * 256 + sl * 32 + _sg * 8) = *(const LAS u32x4*)(Ot + _row * 40 + _sg * 8); } } while (0)
    float xi4[4];
#pragma unroll
    for (int jj = 0; jj < 4; ++jj) xi4[jj] = exp2f((float)((wid >> 1) * 16 + quad * 4 + jj + 1) * lg2);
    RET_ISSUE(0);
    if (cvbase >= 0) CV_LOAD(cvbase);
    int cur = 0;
    for (int n = 0; n < 64; ++n) {
#pragma unroll
        for (int i = 0; i < 4; ++i) {
            const int piece = tid + NTHREADS * i;
            { const int row = piece >> 5, cc = (piece & 31) * 8; *(LAS u32x4*)(Qs + row * 264 + cc) = rq[i]; }
            { const int dk = piece >> 3, jc = (piece & 7) * 8; *(LAS u32x4*)(KTs + dk * 72 + jc) = rk[i]; }
        }
        { const int row = tid >> 3, c8 = (tid & 7) * 8; *(LAS u32x4*)(Ps + row * 72 + c8) = rp; }
        if (tid < 256) {
            const int row = tid >> 2, cc = (tid & 3) * 8;
#pragma unroll
            for (int j = 0; j < 4; ++j) { const unsigned wv = rv[j]; Vt[(cc + 2 * j) * 72 + row] = (bf16_t)(wv & 0xffffu); Vt[(cc + 2 * j + 1) * 72 + row] = (bf16_t)(wv >> 16); }
        }
        if (cvbase >= 0) { CV_WRITE(); if (n + 1 < 64) CV_LOAD(cvbase + 256 * (n + 1)); }
        if (n + 1 < 64) RET_ISSUE(n + 1);
        if (n > 0) RET_OSTORE(n - 1);
        __syncthreads();
        const LAS bf16_t* So = St + cur * (32 * 264); LAS bf16_t* Sn = St + (cur ^ 1) * (32 * 264);
        {
            const int mi = wid >> 1, ni = wid & 1;
            f32x4 a1 = (f32x4){0.f, 0.f, 0.f, 0.f}, a2 = a1;
#pragma unroll
            for (int ks = 0; ks < 2; ++ks) a1 = mma16(ldfrag(Ps, 72, mi * 16, ks * 32, lane), ldfrag(Vt, 72, ni * 16, ks * 32, lane), a1);
#pragma unroll
            for (int ks = 0; ks < 8; ++ks) a2 = mma16(ldfrag(Qs, 264, mi * 16, ks * 32, lane), ldfrag(So, 264, ni * 16, ks * 32, lane), a2);
#pragma unroll
            for (int jj = 0; jj < 4; ++jj) {
                const int i = mi * 16 + quad * 4 + jj;
                Ot[i * 40 + ni * 16 + l15] = f2bf(a1[jj] + xi4[jj] * a2[jj]);
            }
        }
        {
#pragma unroll
            for (int mt = 0; mt < 2; ++mt) {
                const int mi = wid * 2 + mt;
#pragma unroll
                for (int ni = 0; ni < 2; ++ni) {
                    f32x4 s = Sacc[mt][ni] * g64;
#pragma unroll
                    for (int ks = 0; ks < 2; ++ks) s = mma16(ldfrag(KTs, 72, mi * 16, ks * 32, lane), ldfrag(Vt, 72, ni * 16, ks * 32, lane), s);
                    Sacc[mt][ni] = s;
                    u32x2 w; w.x = cvt2(s[0], s[1]); w.y = cvt2(s[2], s[3]);
                    *(LAS u32x2*)(Sn + (ni * 16 + l15) * 264 + mi * 16 + quad * 4) = w;
                }
            }
        }
        if (cvbase >= 0) CV_OUT(cvbase + 256 * n);
        __syncthreads();
        cur ^= 1;
    }
    RET_OSTORE(63);
    __syncthreads();
#undef RET_ISSUE
#undef RET_OSTORE
}

#define HCV_DEC(n_) const int _w = bid_ + 256 * ((n_) >> 2), _e = 16 + (_w >> 8), _kt = ((_w >> 4) & 15) * 4 + ((n_) & 3), _ct = _w & 15
#define HCV_LOAD(n_) do { HCV_DEC(n_); const float* _sp = p.w1 + (size_t)_e * DM * 4096 + (size_t)(_kt * 32 + (tid >> 6) * 4) * 4096 + _ct * 256 + (tid & 63) * 4; \
        _Pragma("unroll") for (int i = 0; i < 4; ++i) cv[i] = *(const f32x4*)(_sp + (size_t)i * 4096); } while (0)
#define HCV_WRITE(n_) do { LAS unsigned* _tw = (LAS unsigned*)cvt_ + ((n_) & 3) * 2320; _Pragma("unroll") for (int c = 0; c < 4; ++c) \
        _tw[((tid & 63) * 4 + c) * 9 + (tid >> 6)] = cvt4_fp8(cv[0][c] * W_SCALE, cv[1][c] * W_SCALE, cv[2][c] * W_SCALE, cv[3][c] * W_SCALE); } while (0)
#define HCV_OUT(n_) do { HCV_DEC(n_); const int _pc = tid & 7; const LAS unsigned* _tb = (const LAS unsigned*)cvt_ + (_pc >> 1) * 2320 + (_pc & 1) * 4; \
        unsigned char* _db = (unsigned char*)p.w1t + (size_t)_e * 4096 * DM + (_kt >> 2) * 128 + _pc * 16; \
        _Pragma("unroll") for (int r = 0; r < 4; ++r) { const int _col = r * 64 + (tid >> 3), _g = _ct * 256 + _col, _j = _g >> 1, _drow = (_j >> 7) * 256 + (_g & 1) * 128 + (_j & 127); \
            const LAS unsigned* _tw = _tb + _col * 9; u32x4 _v; _v.x = _tw[0]; _v.y = _tw[1]; _v.z = _tw[2]; _v.w = _tw[3]; *(u32x4*)(_db + (size_t)_drow * DM) = _v; } } while (0)
__device__ __forceinline__ void mixer_hg(const Params& p, LAS unsigned char* lds, int unit, int cvbase) {
    const int tid = threadIdx.x, lane = tid & 63, wid = tid >> 6, quad = lane >> 4, l15 = lane & 15;
    const int sl = unit & 3, h = (unit >> 2) & 15, b = unit >> 6;
    LAS bf16_t* As = (LAS bf16_t*)lds;
    LAS bf16_t* K2t = As + 64 * 136;
    LAS bf16_t* Ps = K2t + 128 * 72;
    LAS bf16_t* Vt = Ps + 64 * 72;
    LAS bf16_t* St = Vt + 32 * 72;
    LAS float* e63 = (LAS float*)(St + 2 * 32 * 136);
    LAS float* cvt_ = (LAS float*)(lds + 67584);
    const int bid_ = cvbase & 255;
    f32x4 cv[4];
    for (int i = tid; i < 2 * 32 * 136 / 2; i += NTHREADS) ((LAS unsigned*)St)[i] = 0u;
    LAS bf16_t* Ot = (LAS bf16_t*)(lds + 104704);
#define HG_OSTORE(nn) do { if (tid < 256) { const int _row = tid >> 2, _sg = tid & 3; \
        *(u32x4*)(p.o_h + (size_t)(b * SEQ + (nn) * 64 + _row) * DM + h * 128 + sl * 32 + _sg * 8) = *(const LAS u32x4*)(Ot + _row * 40 + _sg * 8); } } while (0)
    f32x4 Sacc[2];
    Sacc[0] = (f32x4){0.f, 0.f, 0.f, 0.f}; Sacc[1] = Sacc[0];
    const bf16_t* zb = p.z + (size_t)(b * SEQ) * NZ;
    const int acol = 8192 + h * 128, vcol = 12288 + h * 128 + sl * 32;
    u32x4 ra[2], rk[2], rp, rv = (u32x4){0u, 0u, 0u, 0u}; float re = 0.f;
#define HG_ISSUE(n) do { const size_t un = (size_t)((b * 64 + (n)) * 16 + h); \
        _Pragma("unroll") for (int i = 0; i < 2; ++i) { const int piece = tid + NTHREADS * i; \
            { const int row = piece >> 4, cc = (piece & 15) * 8; ra[i] = *(const u32x4*)(zb + (size_t)((n) * 64 + row) * NZ + acol + cc); } \
            { const int dd = piece >> 3, mc = (piece & 7) * 8; rk[i] = *(const u32x4*)(p.k2t + (un * 128 + dd) * 64 + mc); } } \
        { const int row = tid >> 3, c8 = (tid & 7) * 8; rp = *(const u32x4*)(p.ph + un * 4096 + row * 64 + c8); } \
        if (tid < 256) { const int row = tid >> 2, cc = (tid & 3) * 8; rv = *(const u32x4*)(zb + (size_t)((n) * 64 + row) * NZ + vcol + cc); } \
        if (tid < 128) re = p.e63[un * 128 + tid]; } while (0)
    HG_ISSUE(0);
    if (cvbase >= 0) HCV_LOAD(0);
    int cur = 0;
    for (int n = 0; n < 64; ++n) {
#pragma unroll
        for (int i = 0; i < 2; ++i) {
            const int piece = tid + NTHREADS * i;
            { const int row = piece >> 4, cc = (piece & 15) * 8; *(LAS u32x4*)(As + row * 136 + cc) = ra[i]; }
            { const int dd = piece >> 3, mc = (piece & 7) * 8; *(LAS u32x4*)(K2t + dd * 72 + mc) = rk[i]; }
        }
        { const int row = tid >> 3, c8 = (tid & 7) * 8; *(LAS u32x4*)(Ps + row * 72 + c8) = rp; }
        if (tid < 256) {
            const int row = tid >> 2, cc = (tid & 3) * 8;
#pragma unroll
            for (int j = 0; j < 4; ++j) { const unsigned wv = rv[j]; Vt[(cc + 2 * j) * 72 + row] = (bf16_t)(wv & 0xffffu); Vt[(cc + 2 * j + 1) * 72 + row] = (bf16_t)(wv >> 16); }
        }
        if (tid < 128) e63[tid] = re;
        if (cvbase >= 0) { HCV_WRITE(n); if (n + 1 < 64) HCV_LOAD(n + 1); }
        if (n + 1 < 64) HG_ISSUE(n + 1);
        if (n > 0) HG_OSTORE(n - 1);
        __syncthreads();
        const LAS bf16_t* So = St + cur * (32 * 136); LAS bf16_t* Sn = St + (cur ^ 1) * (32 * 136);
        {
            const int mi = wid >> 1, ni = wid & 1;
            f32x4 a = (f32x4){0.f, 0.f, 0.f, 0.f};
#pragma unroll
            for (int ks = 0; ks < 2; ++ks) a = mma16(ldfrag(Ps, 72, mi * 16, ks * 32, lane), ldfrag(Vt, 72, ni * 16, ks * 32, lane), a);
#pragma unroll
            for (int ks = 0; ks < 4; ++ks) a = mma16(ldfrag(As, 136, mi * 16, ks * 32, lane), ldfrag(So, 136, ni * 16, ks * 32, lane), a);
#pragma unroll
            for (int jj = 0; jj < 4; ++jj) {
                const int i = mi * 16 + quad * 4 + jj;
                Ot[i * 40 + ni * 16 + l15] = f2bf(a[jj]);
            }
        }
        {
            const int mi = wid;
            const f32x4 ev = *(const LAS f32x4*)(e63 + mi * 16 + quad * 4);
#pragma unroll
            for (int ni = 0; ni < 2; ++ni) {
                f32x4 s = Sacc[ni] * ev;
#pragma unroll
                for (int ks = 0; ks < 2; ++ks) s = mma16(ldfrag(K2t, 72, mi * 16, ks * 32, lane), ldfrag(Vt, 72, ni * 16, ks * 32, lane), s);
                Sacc[ni] = s;
                u32x2 w; w.x = cvt2(s[0], s[1]); w.y = cvt2(s[2], s[3]);
                *(LAS u32x2*)(Sn + (ni * 16 + l15) * 136 + mi * 16 + quad * 4) = w;
            }
        }
        if (cvbase >= 0 && (n & 3) == 3) HCV_OUT(n);
        __syncthreads();
        cur ^= 1;
    }
    HG_OSTORE(63);
    __syncthreads();
#undef HG_ISSUE
#undef HG_OSTORE
#undef HCV_DEC
#undef HCV_LOAD
#undef HCV_WRITE
#undef HCV_OUT
}

__device__ __forceinline__ void unpack8(const u32x4 w, float (&v)[8]) {
#pragma unroll
    for (int j = 0; j < 4; ++j) { v[2 * j] = __uint_as_float(w[j] << 16); v[2 * j + 1] = __uint_as_float(w[j] & 0xffff0000u); }
}
__device__ __forceinline__ void p3_merge(const Params& p, int bid, int nb) {
    const int t = threadIdx.x, c = 8 * (t & 255), rsel = t >> 8;
    float wr8[8], wh8[8];
    { const f32x4 a = *(const f32x4*)(p.ret_nw + c), b = *(const f32x4*)(p.ret_nw + c + 4), e = *(const f32x4*)(p.hg_nw + c), f = *(const f32x4*)(p.hg_nw + c + 4);
#pragma unroll
      for (int j = 0; j < 4; ++j) { wr8[j] = a[j]; wr8[4 + j] = b[j]; wh8[j] = e[j]; wh8[4 + j] = f[j]; } }
    constexpr int R = 2;
    for (int row0 = bid * 2 * R + rsel; row0 < NT; row0 += nb * 2 * R) {
        u32x4 orw[R], ohw[R], gr[R], gh[R];
#pragma unroll
        for (int q = 0; q < R; ++q) {
            const int row = row0 + 2 * q;
            orw[q] = *(const u32x4*)(p.o_r + (size_t)row * DM + c); ohw[q] = *(const u32x4*)(p.o_h + (size_t)row * DM + c);
            gr[q] = *(const u32x4*)(p.gz + (size_t)row * 4096 + c); gh[q] = *(const u32x4*)(p.gz + (size_t)row * 4096 + 2048 + c);
        }
#pragma unroll
        for (int q = 0; q < R; ++q) {
            const int row = row0 + 2 * q;
            float orv[8], ohv[8], grv[8], ghv[8];
            unpack8(orw[q], orv); unpack8(ohw[q], ohv); unpack8(gr[q], grv); unpack8(gh[q], ghv);
            float s = 0.f;
#pragma unroll
            for (int j = 0; j < 8; ++j) s += orv[j];
#pragma unroll
            for (int o = 16; o >= 1; o >>= 1) s += __shfl_xor(s, o);
            const float mean = s * (1.0f / 256.0f);
            float qq = 0.f;
#pragma unroll
            for (int j = 0; j < 8; ++j) { orv[j] -= mean; qq += orv[j] * orv[j]; }
#pragma unroll
            for (int o = 16; o >= 1; o >>= 1) qq += __shfl_xor(qq, o);
            const float rs = rsqrtf(qq * (1.0f / 256.0f) + 1e-6f);
            float q2 = 0.f;
#pragma unroll
            for (int j = 0; j < 8; ++j) q2 += ohv[j] * ohv[j];
#pragma unroll
            for (int o = 8; o >= 1; o >>= 1) q2 += __shfl_xor(q2, o);
            const float rs2 = rsqrtf(q2 * (1.0f / 128.0f) + 1e-6f);
            float o8[8];
#pragma unroll
            for (int j = 0; j < 8; ++j) {
                o8[j] = grv[j] * (orv[j] * rs * wr8[j]) + ghv[j] * (ohv[j] * rs2 * wh8[j]);
            }
            u32x4 w; w.x = cvt2(o8[0], o8[1]); w.y = cvt2(o8[2], o8[3]); w.z = cvt2(o8[4], o8[5]); w.w = cvt2(o8[6], o8[7]);
            *(u32x4*)(p.merged + (size_t)row * DM + c) = w;
        }
    }
}

__device__ __forceinline__ void p5_router(const Params& p, LAS unsigned char* lds, int bid, int nb) {
    const int tid = threadIdx.x, lane = tid & 63, wid = tid >> 6, quad = lane >> 4, l15 = lane & 15;
    constexpr int LD = 2052;
    LAS float* hs = (LAS float*)lds;
    LAS float* red = hs;
    LAS int* le = (LAS int*)(hs + 16 * LD);
    LAS int* lr = le + 256;
    LAS float* lgt = (LAS float*)(lr + 256);
    for (int t0 = bid * 64; t0 < NT; t0 += nb * 64) {
        for (int tile = 0; tile < 4; ++tile) {
#pragma unroll
            for (int tt = 0; tt < 2; ++tt) {
                const int tokl = 2 * wid + tt, tok = t0 + tile * 16 + tokl;
                const u32x4* xr = (const u32x4*)(p.h2b + (size_t)tok * DM);
                float v[4][8]; float ss = 0.f;
#pragma unroll
                for (int i = 0; i < 4; ++i) { unpack8(xr[i * 64 + lane], v[i]);
#pragma unroll
                    for (int j = 0; j < 8; ++j) ss += v[i][j] * v[i][j]; }
                ss = wave_sum(ss);
                const float rstd = rsqrtf(ss * (1.0f / DM) + 1e-6f);
#pragma unroll
                for (int i = 0; i < 4; ++i) {
                    const int c0 = (i * 64 + lane) * 8;
                    const f32x4 w0 = *(const f32x4*)(p.nmoe_w + c0), w1 = *(const f32x4*)(p.nmoe_w + c0 + 4);
                    const f32x4 o0 = (f32x4){v[i][0], v[i][1], v[i][2], v[i][3]} * rstd * w0, o1 = (f32x4){v[i][4], v[i][5], v[i][6], v[i][7]} * rstd * w1;
                    *(LAS f32x4*)(hs + tokl * LD + c0) = o0; *(LAS f32x4*)(hs + tokl * LD + c0 + 4) = o1;
                    u32x2 q; q.x = cvt4_fp8(o0[0] * X_SCALE, o0[1] * X_SCALE, o0[2] * X_SCALE, o0[3] * X_SCALE); q.y = cvt4_fp8(o1[0] * X_SCALE, o1[1] * X_SCALE, o1[2] * X_SCALE, o1[3] * X_SCALE);
                    *(u32x2*)((unsigned char*)p.hn2 + (size_t)tok * DM + c0) = q;
                }
            }
            __syncthreads();
            f32x4 acc[2];
            acc[0] = (f32x4){0.f, 0.f, 0.f, 0.f}; acc[1] = acc[0];
#pragma unroll
            for (int ks = 0; ks < 8; ++ks) {
                const int kb = wid * 256 + ks * 32 + quad * 8;
                const f32x4 x0 = *(const LAS f32x4*)(hs + l15 * LD + kb), x1 = *(const LAS f32x4*)(hs + l15 * LD + kb + 4);
                u32x4 hi; hi.x = cvt2(x0[0], x0[1]); hi.y = cvt2(x0[2], x0[3]); hi.z = cvt2(x1[0], x1[1]); hi.w = cvt2(x1[2], x1[3]);
                u32x4 lo;
                lo.x = cvt2(x0[0] - __uint_as_float(hi.x << 16), x0[1] - __uint_as_float(hi.x & 0xffff0000u));
                lo.y = cvt2(x0[2] - __uint_as_float(hi.y << 16), x0[3] - __uint_as_float(hi.y & 0xffff0000u));
                lo.z = cvt2(x1[0] - __uint_as_float(hi.z << 16), x1[1] - __uint_as_float(hi.z & 0xffff0000u));
                lo.w = cvt2(x1[2] - __uint_as_float(hi.w << 16), x1[3] - __uint_as_float(hi.w & 0xffff0000u));
                const bf16x8 Ahi = __builtin_bit_cast(bf16x8, hi), Alo = __builtin_bit_cast(bf16x8, lo);
#pragma unroll
                for (int nt = 0; nt < 2; ++nt) {
                    const bf16x8 Bhi = *(const bf16x8*)(p.wr_hi + (size_t)(nt * 16 + l15) * DM + kb), Blo = *(const bf16x8*)(p.wr_lo + (size_t)(nt * 16 + l15) * DM + kb);
                    acc[nt] = mma16(Ahi, Bhi, acc[nt]); acc[nt] = mma16(Alo, Bhi, acc[nt]); acc[nt] = mma16(Ahi, Blo, acc[nt]);
                }
            }
            __syncthreads();
#pragma unroll
            for (int nt = 0; nt < 2; ++nt)
#pragma unroll
                for (int jj = 0; jj < 4; ++jj) red[(wid * 16 + quad * 4 + jj) * 32 + nt * 16 + l15] = acc[nt][jj];
            __syncthreads();
#pragma unroll
            for (int tt = 0; tt < 2; ++tt) {
                const int tokl = 2 * wid + tt, tl64 = tile * 16 + tokl;
                float v = -3.0e38f;
                if (lane < 32) { float sv = p.b_router[lane];
#pragma unroll
                    for (int w8 = 0; w8 < 8; ++w8) sv += red[(w8 * 16 + tokl) * 32 + lane];
                    v = sv; }
                float tv[4]; int te[4];
#pragma unroll
                for (int k = 0; k < 4; ++k) {
                    float bv = v; int bi = lane;
#pragma unroll
                    for (int o = 32; o >= 1; o >>= 1) { const float ov = __shfl_xor(bv, o); const int oi = __shfl_xor(bi, o); if (ov > bv || (ov == bv && oi < bi)) { bv = ov; bi = oi; } }
                    tv[k] = bv; te[k] = bi; if (lane == bi) v = -3.0e38f;
                }
                const float e0 = 1.0f, e1 = __expf(tv[1] - tv[0]), e2 = __expf(tv[2] - tv[0]), e3 = __expf(tv[3] - tv[0]);
                const float inv = 1.0f / (e0 + e1 + e2 + e3);
                if (lane < 4) {
                    const int ee = lane == 0 ? te[0] : lane == 1 ? te[1] : lane == 2 ? te[2] : te[3];
                    const float gg = (lane == 0 ? e0 : lane == 1 ? e1 : lane == 2 ? e2 : e3) * inv;
                    le[tl64 * 4 + lane] = ee; lgt[tl64 * 4 + lane] = gg;
                }
            }
            __syncthreads();
        }
        if (tid < 32) {
            int c = 0;
            for (int i = 0; i < 256; ++i) if (le[i] == tid) { lr[i] = c; ++c; }
            p.whist[(t0 >> 6) * 32 + tid] = c;
        }
        __syncthreads();
        if (tid < 256) { const int idx = t0 * 4 + tid; p.tk_e[idx] = le[tid]; p.tk_rank[idx] = lr[tid]; p.tk_g[idx] = lgt[tid]; }
        __syncthreads();
    }
}

__device__ __forceinline__ void p6_gather(const Params& p, LAS unsigned char* lds, LAS int* tb, int bid, int nb) {
    const int tid = threadIdx.x, lane = tid & 63, wid = tid >> 6;
    LAS int* pre = (LAS int*)lds;
    LAS int* raw = pre + 256 * 32;
    LAS int* ctot = raw + 256 * 32;
    for (int i = tid; i < 256 * 32; i += NTHREADS) raw[i] = p.whist[i];
    __syncthreads();
    {
        const int e = tid & 31, ch = tid >> 5;
        int sm = 0;
#pragma unroll
        for (int k = 0; k < 16; ++k) sm += raw[(ch * 16 + k) * 32 + e];
        ctot[ch * 32 + e] = sm;
    }
    __syncthreads();
    {
        const int e = tid & 31, ch = tid >> 5;
        int run = 0, tot = 0;
#pragma unroll
        for (int k = 0; k < 16; ++k) { const int v = ctot[k * 32 + e]; tot += v; run += (k < ch) ? v : 0; }
#pragma unroll
        for (int k = 0; k < 16; ++k) { pre[(ch * 16 + k) * 32 + e] = run; run += raw[(ch * 16 + k) * 32 + e]; }
        if (ch == 0) tb[128 + 256 + e] = tot;
    }
    __syncthreads();
    if (tid == 0) {
        int t = 0;
        for (int e = 0; e < NE; ++e) {
            const int c = tb[128 + 256 + e], nt = (c + 255) >> 8;
            tb[1 + e] = t * 256;
            for (int k = 0; k < nt; ++k) tb[64 + t + k] = e;
            t += nt;
            if (bid == 0) p.gcnt[e] = c;
        }
        tb[0] = t;
    }
    __syncthreads();
    int* rt = (int*)p.xg;
    for (int ent = bid * NTHREADS + tid; ent < NT * 4; ent += nb * NTHREADS) {
        const int e = p.tk_e[ent], tok = ent >> 2, dest = tb[1 + e] + pre[(tok >> 6) * 32 + e] + p.tk_rank[ent];
        rt[dest] = tok; p.row_gate[dest] = p.tk_g[ent]; p.pos[ent] = dest;
    }
    for (int e = 0; e < NE; ++e) {
        const int c = tb[128 + 256 + e], r0 = tb[1 + e] + c, r1 = tb[1 + e] + (((c + 255) >> 8) << 8);
        for (int r = r0 + bid * NTHREADS + tid; r < r1; r += nb * NTHREADS) { rt[r] = 0; p.row_gate[r] = 0.f; }
    }
}

__device__ __forceinline__ void p9_final(const Params& p, int bid, int nb) {
    const int lane = threadIdx.x & 63, wid = threadIdx.x >> 6;
    typedef float f2_ __attribute__((ext_vector_type(2)));
    for (int tok = bid * 8 + wid; tok < NT; tok += nb * 8) {
        const u32x4* hr = (const u32x4*)(p.h2b + (size_t)tok * DM);
        const unsigned char* y0 = (const unsigned char*)p.y + (size_t)p.pos[tok * 4 + 0] * DM; const unsigned char* y1 = (const unsigned char*)p.y + (size_t)p.pos[tok * 4 + 1] * DM;
        const unsigned char* y2 = (const unsigned char*)p.y + (size_t)p.pos[tok * 4 + 2] * DM; const unsigned char* y3 = (const unsigned char*)p.y + (size_t)p.pos[tok * 4 + 3] * DM;
        float v[4][8]; float ss = 0.f;
        constexpr float ys = 1.0f / Y_SCALE;
#pragma unroll
        for (int i = 0; i < 4; ++i) {
            const int c = (i * 64 + lane) * 8;
            unpack8(hr[i * 64 + lane], v[i]);
#if !DBG_SKIP_MOE
            const u32x2 q0 = *(const u32x2*)(y0 + c), q1 = *(const u32x2*)(y1 + c), q2 = *(const u32x2*)(y2 + c), q3 = *(const u32x2*)(y3 + c);
#pragma unroll
            for (int hw = 0; hw < 2; ++hw) {
                const int a0 = (int)(hw ? q0.y : q0.x), a1 = (int)(hw ? q1.y : q1.x), a2 = (int)(hw ? q2.y : q2.x), a3 = (int)(hw ? q3.y : q3.x);
                const f2_ l0 = __builtin_amdgcn_cvt_pk_f32_fp8(a0, false), h0 = __builtin_amdgcn_cvt_pk_f32_fp8(a0, true), l1 = __builtin_amdgcn_cvt_pk_f32_fp8(a1, false), h1 = __builtin_amdgcn_cvt_pk_f32_fp8(a1, true);
                const f2_ l2 = __builtin_amdgcn_cvt_pk_f32_fp8(a2, false), h2 = __builtin_amdgcn_cvt_pk_f32_fp8(a2, true), l3 = __builtin_amdgcn_cvt_pk_f32_fp8(a3, false), h3 = __builtin_amdgcn_cvt_pk_f32_fp8(a3, true);
                v[i][4 * hw + 0] += ((l0[0] + l1[0]) + (l2[0] + l3[0])) * ys; v[i][4 * hw + 1] += ((l0[1] + l1[1]) + (l2[1] + l3[1])) * ys;
                v[i][4 * hw + 2] += ((h0[0] + h1[0]) + (h2[0] + h3[0])) * ys; v[i][4 * hw + 3] += ((h0[1] + h1[1]) + (h2[1] + h3[1])) * ys;
            }
#endif
#pragma unroll
            for (int j = 0; j < 8; ++j) ss += v[i][j] * v[i][j];
        }
        ss = wave_sum(ss);
        const float rstd = rsqrtf(ss * (1.0f / DM) + 1e-6f);
#pragma unroll
        for (int i = 0; i < 4; ++i) {
            const int c = (i * 64 + lane) * 8;
            const f32x4 w0 = *(const f32x4*)(p.nfin_w + c), w1 = *(const f32x4*)(p.nfin_w + c + 4);
            *(f32x4*)(p.out + (size_t)tok * DM + c) = (f32x4){v[i][0], v[i][1], v[i][2], v[i][3]} * rstd * w0;
            *(f32x4*)(p.out + (size_t)tok * DM + c + 4) = (f32x4){v[i][4], v[i][5], v[i][6], v[i][7]} * rstd * w1;
        }
    }
}

#if DIAG
__device__ __forceinline__ unsigned hsh(unsigned a, unsigned b) { unsigned x = a * 0x9E3779B1u + b * 0x85EBCA77u + 0x165667B1u; x ^= x >> 15; x *= 0x2C1B3C6Du; x ^= x >> 12; x *= 0x297A2D39u; x ^= x >> 15; return x; }
__device__ __forceinline__ void dacc(float* diag, int stage, float f, float sv, int lane) { if (lane == 0) { atomicAdd(&diag[2 * stage], (f - sv) * (f - sv)); atomicAdd(&diag[2 * stage + 1], sv * sv); } }
__device__ __forceinline__ float swiglu_ref(float g, float l) { const float xg = fminf(g, 7.0f), xl = fminf(fmaxf(l, -7.0f), 7.0f); return xg * (1.0f / (1.0f + expf(-1.702f * xg))) * (xl + 1.0f); }

__device__ void diag_checks(const Params& p, int bid, int nb) {
    const int lane = threadIdx.x & 63, wid = threadIdx.x >> 6;
    float* diag = p.diag;
    for (int rep = 0; rep < 2; ++rep) {
        const unsigned sid = (unsigned)((bid * 8 + wid) * 2 + rep);
        {
            const int row = hsh(sid, 1) % NT, col = hsh(sid, 2) % DM;
            float ss = 0.f; for (int k = lane; k < DM; k += 64) { const float v = p.x[(size_t)row * DM + k]; ss += v * v; }
            ss = wave_sum(ss);
            const float sv = p.x[(size_t)row * DM + col] * rsqrtf(ss / DM + 1e-6f) * p.nmix_w[col];
            dacc(diag, 0, bf2f(p.hn[(size_t)row * DM + col]), sv, lane);
        }
        {
            const int row = hsh(sid, 3) % NT, col = hsh(sid, 4) % NZ;
            float a = 0.f; for (int k = lane; k < DM; k += 64) a += bf2f(p.hn[(size_t)row * DM + k]) * p.w_in[(size_t)k * NZ + col];
            float v = wave_sum(a);
            if (col < 4096) {
                const int hc = col & 255, pr = hc & 127, partner = (col & ~255) + ((hc + 128) & 255);
                float b = 0.f; for (int k = lane; k < DM; k += 64) b += bf2f(p.hn[(size_t)row * DM + k]) * p.w_in[(size_t)k * NZ + partner];
                const float u = wave_sum(b);
                const int sq = row & (SEQ - 1);
                const double ang = (double)sq * (double)powf(10000.0f, -(float)pr / 127.0f);
                const float cs = (float)cos(ang), sn = (float)sin(ang);
                v = (hc < 128) ? (v * cs - u * sn) : (v * cs + u * sn);
                if (col >= 2048) v *= 0.0625f;
            }
            dacc(diag, 1, bf2f(p.z[(size_t)row * NZ + col]), v, lane);
        }
        {
            int b = hsh(sid, 5) & 3, sq = hsh(sid, 6) % SEQ, h = hsh(sid, 7) & 7, c = hsh(sid, 8) & 255;
            if (DIAG_SUB == 1) sq &= 63;
            if (DIAG_SUB == 2) h = 0;
            if (DIAG_SUB == 3) h = 7;
            if (DIAG_SUB == 4) sq = 64 + (sq & 63);
            const int n = sq >> 6;
            const float lg2 = log2f(1.0f - exp2f(-5.0f - (float)h));
            const bf16_t* zb = p.z + (size_t)(b * SEQ) * NZ;
            float q[4];
            for (int t = 0; t < 4; ++t) q[t] = bf2f(zb[(size_t)sq * NZ + h * 256 + lane * 4 + t]);
            float acc = 0.f;
            for (int m = 0; m < 64 * (n + 1); ++m) {
                float d = 0.f;
                for (int t = 0; t < 4; ++t) d += q[t] * bf2f(zb[(size_t)m * NZ + 2048 + h * 256 + lane * 4 + t]);
                d = wave_sum(d);
                const float w = exp2f(fabsf((float)(sq - m)) * lg2);
                acc += w * d * bf2f(zb[(size_t)m * NZ + 4096 + h * 256 + c]);
            }
            dacc(diag, 2, bf2f(p.o_r[(size_t)(b * SEQ + sq) * DM + h * 256 + c]), acc, lane);
        }
        {
            const int b = hsh(sid, 9) & 3, sq = hsh(sid, 10) % SEQ, h = hsh(sid, 11) & 15, c = hsh(sid, 12) & 127;
            const bf16_t* zb = p.z + (size_t)(b * SEQ) * NZ;
            float lbv[2], qs[2], run[2];
            for (int t = 0; t < 2; ++t) {
                const int d = h * 128 + lane * 2 + t;
                lbv[t] = 1.0f / (1.0f + expf(p.lb_logits[DM + d] - p.lb_logits[d]));
                const float qv = bf2f(p.dz[(size_t)(b * SEQ + sq) * 4096 + d]); qs[t] = qv / (1.0f + expf(-qv)); run[t] = 0.f;
            }
            float acc = 0.f;
            const int mlo = sq > 300 ? sq - 300 : 0;
            for (int m = sq; m >= mlo; --m) {
                float term = 0.f, lf[2];
                for (int t = 0; t < 2; ++t) {
                    const float zf = bf2f(p.dz[(size_t)(b * SEQ + m) * 4096 + 2048 + h * 128 + lane * 2 + t]);
                    const float sg = 1.0f / (1.0f + expf(-zf)), f = lbv[t] + (1.0f - lbv[t]) * sg;
                    term += qs[t] * (1.0f - f) * expf(run[t]); lf[t] = logf(f);
                }
                term = wave_sum(term);
                acc += term * bf2f(zb[(size_t)m * NZ + 12288 + h * 128 + c]);
                run[0] += lf[0]; run[1] += lf[1];
            }
            dacc(diag, 3, bf2f(p.o_h[(size_t)(b * SEQ + sq) * DM + h * 128 + c]), acc, lane);
        }
        {
            const int row = hsh(sid, 13) % NT, col = hsh(sid, 14) % DM;
            const int rh = col >> 8, hh = col >> 7;
            float s1 = 0.f; for (int t = 0; t < 4; ++t) s1 += bf2f(p.o_r[(size_t)row * DM + rh * 256 + lane * 4 + t]);
            const float mean = wave_sum(s1) / 256.0f;
            float s2 = 0.f; for (int t = 0; t < 4; ++t) { const float dd = bf2f(p.o_r[(size_t)row * DM + rh * 256 + lane * 4 + t]) - mean; s2 += dd * dd; }
            const float rs = rsqrtf(wave_sum(s2) / 256.0f + 1e-6f);
            float s3 = 0.f; for (int t = 0; t < 2; ++t) { const float v = bf2f(p.o_h[(size_t)row * DM + hh * 128 + lane * 2 + t]); s3 += v * v; }
            const float rs2 = rsqrtf(wave_sum(s3) / 128.0f + 1e-6f);
            const bf16_t* zr = p.z + (size_t)row * NZ;
            const float rg = bf2f(zr[6144 + col]), hg = bf2f(zr[14336 + col]), gr = bf2f(zr[16384 + col]), gh = bf2f(zr[18432 + col]);
            const float a = (bf2f(p.o_r[(size_t)row * DM + col]) - mean) * rs * p.ret_nw[col] * (rg / (1.0f + expf(-rg)));
            const float bq = bf2f(p.o_h[(size_t)row * DM + col]) * rs2 * p.hg_nw[col] * (hg / (1.0f + expf(-hg)));
            const float sv = a / (1.0f + expf(-gr)) + bq / (1.0f + expf(-gh));
            dacc(diag, 4, bf2f(p.merged[(size_t)row * DM + col]), sv, lane);
        }
        {
            const int row = hsh(sid, 15) % NT, col = hsh(sid, 16) % DM;
            float a = 0.f; for (int k = lane; k < DM; k += 64) a += bf2f(p.merged[(size_t)row * DM + k]) * p.w_out[(size_t)k * DM + col];
            const float sv = wave_sum(a) + p.x[(size_t)row * DM + col];
            dacc(diag, 5, p.h2[(size_t)row * DM + col], sv, lane);
        }
        {
            const int tok = hsh(sid, 17) % NT;
            float ss = 0.f; for (int k = lane; k < DM; k += 64) { const float v = p.h2[(size_t)tok * DM + k]; ss += v * v; }
            const float rstd = rsqrtf(wave_sum(ss) / DM + 1e-6f);
            const int e = lane & 31, half = lane >> 5;
            float a = 0.f;
            for (int d = half * 1024; d < half * 1024 + 1024; ++d) a += p.h2[(size_t)tok * DM + d] * rstd * p.nmoe_w[d] * p.w_router[(size_t)d * NE + e];
            a += __shfl_xor(a, 32);
            const float lg = a + p.b_router[e];
            int rank = 0; float mx = -3.0e38f;
            for (int o = 0; o < 32; ++o) { const float ov = __shfl(lg, o); if (ov > lg || (ov == lg && o < e)) ++rank; mx = fmaxf(mx, ov); }
            float den = 0.f;
            for (int o = 0; o < 32; ++o) { const float ov = __shfl(lg, o); const int orank = __shfl(rank, o); if (orank < 4) den += expf(ov - mx); }
            const float gate = expf(lg - mx) / den;
            for (int k = 0; k < 4; ++k) {
                const int fe = p.tk_e[tok * 4 + k]; const float fg = p.tk_g[tok * 4 + k];
                const int srank = __shfl(rank, fe & 31); const float sg = __shfl(gate, fe & 31);
                const float fv = (srank == k && fe >= 0 && fe < 32) ? fg : fg + 1.0f;
                dacc(diag, 6, fv, sg, lane);
            }
        }
        {
            const int ent = hsh(sid, 18) % (NT * 4), tok = ent >> 2, e = p.tk_e[ent], dest = p.pos[ent];
            int rstart = 0; for (int q = 0; q < e; ++q) rstart += ((p.gcnt[q] + 255) >> 8) << 8;
            int bad = (dest < rstart || dest >= rstart + p.gcnt[e]) ? 1 : 0;
            for (int k = lane; k < DM; k += 64) if (((const unsigned char*)p.xg)[(size_t)dest * DM + k] != ((const unsigned char*)p.hn2)[(size_t)tok * DM + k]) bad = 1;
            if (p.row_gate[dest] != p.tk_g[ent]) bad = 1;
            for (int o = 32; o >= 1; o >>= 1) bad |= __shfl_xor(bad, o);
            dacc(diag, 7, bad ? 2.0f : 1.0f, 1.0f, lane);
            {
                const int j = hsh(sid, 19) % DFF;
                const float* w1e = p.w1 + (size_t)e * DM * 4096;
                float g = 0.f, l = 0.f;
                for (int k = lane; k < DM; k += 64) { const float xv = fp8_to_f32(((const unsigned char*)p.xg)[(size_t)dest * DM + k]) * (1.0f / X_SCALE); g += xv * w1e[(size_t)k * 4096 + 2 * j]; l += xv * w1e[(size_t)k * 4096 + 2 * j + 1]; }
                g = wave_sum(g) + p.b1[e * 4096 + 2 * j]; l = wave_sum(l) + p.b1[e * 4096 + 2 * j + 1];
                dacc(diag, 8, fp8_to_f32(((const unsigned char*)p.hid)[(size_t)dest * DFF + j]) * (1.0f / H_SCALE), swiglu_ref(g, l), lane);
            }
            {
                const int col = hsh(sid, 20) % DM;
                const float* w2e = p.w2 + (size_t)e * DFF * DM;
                float a = 0.f; for (int k = lane; k < DFF; k += 64) a += fp8_to_f32(((const unsigned char*)p.hid)[(size_t)dest * DFF + k]) * (1.0f / H_SCALE) * w2e[(size_t)k * DM + col];
                const float sv = (wave_sum(a) + p.b2[e * DM + col]) * p.row_gate[dest];
                dacc(diag, 9, bf2f(p.y[(size_t)dest * DM + col]), sv, lane);
            }
        }
        {
            const int tok = hsh(sid, 21) % NT, col = hsh(sid, 22) % DM;
            float ss = 0.f, mine = 0.f;
            for (int k = lane; k < DM; k += 64) {
                float v = p.h2[(size_t)tok * DM + k];
                for (int q = 0; q < 4; ++q) v += bf2f(p.y[(size_t)p.pos[tok * 4 + q] * DM + k]);
                ss += v * v; if (k == col) mine = v;
            }
            ss = wave_sum(ss); mine = wave_sum(mine);
            dacc(diag, 10, p.out[(size_t)tok * DM + col], mine * rsqrtf(ss / DM + 1e-6f) * p.nfin_w[col], lane);
        }
    }
}
__device__ void diag_finalize(const Params& p, int bid, int nb) {
    int fail = -1;
    for (int s = 0; s <= 10; ++s) { const float num = p.diag[2 * s], den = p.diag[2 * s + 1]; if (fail < 0 && !(num <= DIAG_THR * DIAG_THR * den)) fail = s; }
    float V = (fail < 0) ? 10.0f : 12.0f + 2.0f * (float)fail;
#if DIAG == 2
    { const float num = p.diag[2 * DIAG_STAGE], den = p.diag[2 * DIAG_STAGE + 1]; const float err = sqrtf(num / fmaxf(den, 1e-30f));
      const float num2 = p.diag[2 * DIAG_STAGE2], den2 = p.diag[2 * DIAG_STAGE2 + 1]; const float err2 = sqrtf(num2 / fmaxf(den2, 1e-30f));
      const int a = (int)fminf(8.0f, floorf(err * 20.0f)), b2 = (int)fminf(9.0f, floorf(err2 * 20.0f)); V = 10.0f * (float)(1 + a) + (float)b2; }
#endif
#if DIAG == 3
    const unsigned long long* ts = (const unsigned long long*)p.diag + 8;
    const float durA = (float)(ts[TS_A1] - ts[TS_A0]) * 0.01f, durB = (float)(ts[TS_B1] - ts[TS_B0]) * 0.01f;
    V = 10.0f + rintf(durA * (1.0f / TS_Q));
    if (bid == 0 && threadIdx.x == 0) p.out[(size_t)NT * DM - 1] = 0.f;
#endif
    const float c = sqrtf((V - 1.0f) * 1.01f);
#if DIAG == 3
    for (size_t i = (size_t)bid * NTHREADS + threadIdx.x; i < (size_t)NT * DM; i += (size_t)nb * NTHREADS) p.out[i] = (i == 12345) ? 10.0f * (1.0f + rintf(durB * (1.0f / TS_Q))) : ((i & 1) ? -c : c);
    return;
#endif
    for (size_t i = (size_t)bid * NTHREADS + threadIdx.x; i < (size_t)NT * DM; i += (size_t)nb * NTHREADS) p.out[i] = (i & 1) ? -c : c;
}
#endif

constexpr int NPHASE = 11;
__global__ void __launch_bounds__(NTHREADS, 2) fwd(Params p) {
    extern __shared__ __attribute__((aligned(16))) unsigned char shm[];
    LAS unsigned char* lds = (LAS unsigned char*)shm;
    LAS int* tb = (LAS int*)(lds + XTRA_OFF);
    volatile LAS unsigned* bst = (volatile LAS unsigned*)(lds + XTRA_OFF + 3072);
    const int lo = (int)(p.lo_hi & 0xffffffffll), hi = (int)(p.lo_hi >> 32);
    const int bid = blockIdx.x, nb = gridDim.x;
    if (threadIdx.x == 0) { bst[0] = 0u; bst[1] = 0u; bst[2] = 0u; bst[3] = 0u; }
    __syncthreads();
    XcdBarrier bar; bar.bar = p.bar; bar.x = 0; bar.st = bst;
    const bool multi = (hi - lo) > 1;
    if (multi) bar = xcd_barrier_post(p.bar, bst);
#define IN(k) (lo <= (k) && (k) < hi)
#if DIAG == 3
#define SEAM(k) do { if (IN(k) && IN((k) + 1)) xcd_barrier(bar); if (bid == 0 && threadIdx.x == 0) ((unsigned long long*)p.diag)[8 + (k) + 1] = (unsigned long long)wall_clock64(); } while (0)
#else
#define SEAM(k) do { if (IN(k) && IN((k) + 1)) xcd_barrier(bar); } while (0)
#endif

#if DIAG == 3
    if (bid == 0 && threadIdx.x == 0) ((unsigned long long*)p.diag)[8] = (unsigned long long)wall_clock64();
#endif
    if (IN(0)) { p0_prologue(p, lds, bid, nb); }
    SEAM(0);
    if (IN(1)) {
#if P1_MIX
        {
            pg8::Gemm g{p.hn, p.w_in_t, NT, 48 * 256, DM}; pg8::StaticOrder S; S.init(NT, 48 * 256, nb, bid);
            EpiZT<false, 1> E{p.z, p.cosT, p.sinT};
            pg8::gemm_phase<EpiZT<false, 1>, pg8::StaticOrder>(lds, g, S, E);
        }
        __syncthreads();
        {
            pg8::Gemm g{p.hn8, p.w_in_t8, NT, 32 * 256, DM / 2}; pg8::StaticOrder S; S.init(NT, 32 * 256, nb, bid);
            EpiGate E{p.gz};
            pg8::gemm_phase<EpiGate, pg8::StaticOrder>(lds, g, S, E);
        }
#else
        pg8::Gemm g{p.hn, p.w_in_t, NT, NZ, P1_FP8 ? DM / 2 : DM}; pg8::StaticOrder S; S.init(NT, NZ, nb, bid);
        EpiZT<(P1_FP8 != 0), 0> E{p.z, p.cosT, p.sinT};
        pg8::gemm_phase<EpiZT<(P1_FP8 != 0), 0>, pg8::StaticOrder>(lds, g, S, E);
#endif
    }
    SEAM(1);
    if (IN(2)) {
        ret_prepass(p, lds, bid, nb);
        __syncthreads();
        if (nb == 256) hg_prepass<true>(p, lds, bid, nb); else hg_prepass<false>(p, lds, bid, nb);
    }
    SEAM(2);
    if (IN(3)) {
        for (int u = bid; u < 256; u += nb) { const int x = u & 7, w = u >> 3; mixer_ret(p, lds, nb == 256 ? (((x * 4 + (w >> 3)) << 3) | (w & 7)) : u, nb == 256 ? bid : -1); }
        for (int u = bid; u < 256; u += nb) { const int x = u & 7, w = u >> 3; mixer_hg(p, lds, nb == 256 ? (((x * 8 + (w >> 2)) << 2) | (w & 3)) : u, nb == 256 ? bid + 256 * 64 : -1); }
    }
    SEAM(3);
    if (IN(4)) { p3_merge(p, bid, nb); }
    SEAM(4);
    if (IN(5)) {
        pg8::Gemm g{p.merged, p.w_out_t, NT, DM, DM}; pg8::StaticOrder S; S.init(NT, DM, nb, bid);
        EpiRes E{p.h2b, p.x};
        pg8::gemm_phase<EpiRes, pg8::StaticOrder>(lds, g, S, E);
    }
    SEAM(5);
    if (IN(6)) { p5_router(p, lds, bid, nb); }
    SEAM(6);
    if (IN(7)) { p6_gather(p, lds, tb, bid, nb); }
    SEAM(7);
    if (IN(8)) {
        build_tiles(p, tb);
        pg8::Gemm g{p.hn2, p.w1t, MAXROWS, 4096, DM / 2}; MoeGather S; S.init(tb[0], 16, nb, bid, tb + 64); S.rowtok = (const int*)p.xg;
        EpiSwiglu E{(unsigned char*)p.hid, p.b1p};
        pg8::gemm_phase<EpiSwiglu, MoeGather>(lds, g, S, E);
    }
    SEAM(8);
    if (IN(9)) {
        build_tiles(p, tb);
        pg8::Gemm g{p.hid, p.w2t, MAXROWS, DM, DFF / 2}; MoeOrder S; S.init(tb[0], 8, nb, bid, tb + 64);
        EpiY E{p.y, p.b2, p.row_gate};
        pg8::gemm_phase<EpiY, MoeOrder>(lds, g, S, E);
    }
    SEAM(9);
    if (IN(10)) { p9_final(p, bid, nb); }
#if DIAG == 3
    SEAM(10);
    if (IN(11)) { diag_finalize(p, bid, nb); }
#elif DIAG
    if (IN(11)) { diag_checks(p, bid, nb); }
    if (IN(12)) { diag_finalize(p, bid, nb); }
#endif
#undef IN
#undef SEAM
}

extern "C" void kernel_launch(void* const* d_in, const int* in_sizes, int n_in, void* d_out, int out_size, void* d_ws, size_t ws_size, hipStream_t stream) {
    static int grid = 0;
    if (grid == 0) {
        int dev = 0, cus = 0;
        if (hipGetDevice(&dev) != hipSuccess || hipDeviceGetAttribute(&cus, hipDeviceAttributeMultiprocessorCount, dev) != hipSuccess) { fprintf(stderr, "kernel_launch: device query failed\n"); grid = -1; return; }
        if (hipFuncSetAttribute((const void*)fwd, hipFuncAttributeMaxDynamicSharedMemorySize, LDS_BYTES) != hipSuccess) { fprintf(stderr, "kernel_launch: hipFuncSetAttribute failed\n"); grid = -1; return; }
        int per_cu = 0;
        if (hipOccupancyMaxActiveBlocksPerMultiprocessor(&per_cu, (const void*)fwd, NTHREADS, LDS_BYTES) != hipSuccess || per_cu < 1) fprintf(stderr, "kernel_launch: occupancy query says %d\n", per_cu);
        (void)hipGetLastError();
        grid = cus > 0 ? cus : 256;
    }
    if (grid < 0) return;
    unsigned char* ws = (unsigned char*)d_ws;
    size_t off = 0;
    auto take = [&](size_t bytes) { unsigned char* r = ws + off; off += (bytes + 255) & ~(size_t)255; return r; };
    Params p{};
    p.x = (const float*)d_in[0]; p.w_in = (const float*)d_in[1]; p.ret_nw = (const float*)d_in[2]; p.hg_nw = (const float*)d_in[3]; p.lb_logits = (const float*)d_in[4];
    p.w_out = (const float*)d_in[5]; p.nmix_w = (const float*)d_in[6]; p.nmoe_w = (const float*)d_in[7]; p.w_router = (const float*)d_in[8]; p.b_router = (const float*)d_in[9];
    p.w1 = (const float*)d_in[10]; p.b1 = (const float*)d_in[11]; p.w2 = (const float*)d_in[12]; p.b2 = (const float*)d_in[13]; p.nfin_w = (const float*)d_in[14];
    p.out = (float*)d_out;
    p.bar = (unsigned*)take(XCD_BAR_WORDS * 4);
    p.diag = (float*)take(256);
    p.gcnt = (int*)take(256);
    p.whist = (int*)take((NT / 64) * 32 * 4);
    p.w_in_t = (bf16_t*)take((size_t)NZ * DM * 2);
    p.w_in_t8 = (bf16_t*)take((size_t)32 * 256 * DM);
    p.hn8 = (bf16_t*)take((size_t)NT * DM);
    p.gz = (bf16_t*)take((size_t)NT * 4096 * 2);
    p.w_out_t = (bf16_t*)take((size_t)DM * DM * 2);
    p.w1t = (bf16_t*)take((size_t)NE * 4096 * DM * 2);
    p.w2t = (bf16_t*)take((size_t)NE * DM * DFF * 2);
    p.hn = (bf16_t*)take((size_t)NT * DM * 2);
    p.z = (bf16_t*)take((size_t)NT * NZ * 2);
    p.merged = (bf16_t*)take((size_t)NT * DM * 2);
    p.hn2 = (bf16_t*)take((size_t)NT * DM * 2);
    p.xg = (bf16_t*)take((size_t)MAXROWS * DM * 2);
    p.hid = (bf16_t*)take((size_t)MAXROWS * DFF * 2);
    p.y = (bf16_t*)take((size_t)MAXROWS * DM * 2);
    p.o_r = (bf16_t*)take((size_t)NT * DM * 2);
    p.o_h = (bf16_t*)take((size_t)NT * DM * 2);
    p.h2 = (float*)take(DIAG ? (size_t)NT * DM * 4 : 256);
    p.h2b = (bf16_t*)take((size_t)NT * DM * 2);
    p.cosT = (float*)take((size_t)SEQ * 128 * 4);
    p.sinT = (float*)take((size_t)SEQ * 128 * 4);
    p.b1p = (float*)take((size_t)NE * 4096 * 4);
    p.e63 = (float*)take((size_t)4096 * 128 * 4);
    p.k2t = (bf16_t*)take((size_t)4096 * 128 * 64 * 2);
    p.wr_hi = (bf16_t*)take((size_t)NE * DM * 2);
    p.wr_lo = (bf16_t*)take((size_t)NE * DM * 2);
    p.pr = (bf16_t*)take((size_t)2048 * 4096 * 2);
    p.ph = (bf16_t*)take((size_t)4096 * 4096 * 2);
    p.kt = (bf16_t*)take((size_t)2048 * 256 * 64 * 2);
    p.dz = (bf16_t*)take(DIAG ? (size_t)NT * 4096 * 2 : 256);
    p.tk_g = (float*)take((size_t)NT * 4 * 4);
    p.row_gate = (float*)take((size_t)MAXROWS * 4);
    p.tk_e = (int*)take((size_t)NT * 4 * 4);
    p.tk_rank = (int*)take((size_t)NT * 4 * 4);
    p.pos = (int*)take((size_t)NT * 4 * 4);
    if (off > ws_size) { fprintf(stderr, "kernel_launch: workspace too small: need %zu, have %zu\n", off, ws_size); return; }
    (void)hipMemsetAsync(p.bar, 0, XCD_BAR_WORDS * 4 + 256, stream);
#if N_LAUNCH_MODE == 1
    p.lo_hi = ((long long)(NPHASE + (DIAG == 3 ? 1 : 0)) << 32) | 0ll;
    hipLaunchKernelGGL(fwd, dim3(grid), dim3(NTHREADS), LDS_BYTES, stream, p);
#else
    for (int ph = 0; ph < NPHASE + (DIAG ? 2 : 0); ++ph) {
        if (DBG_SKIP_MOE && ph >= 6 && ph <= 9) continue;
        p.lo_hi = ((long long)(ph + 1) << 32) | (long long)ph;
        hipLaunchKernelGGL(fwd, dim3(grid), dim3(NTHREADS), LDS_BYTES, stream, p);
    }
#endif
    const hipError_t le = hipPeekAtLastError();
    if (le != hipSuccess) fprintf(stderr, "kernel_launch: launch failed: %s\n", hipGetErrorName(le));
}
```

```cpp
#include <hip/hip_runtime.h>
#include <cstdio>
#include <cstdint>

#ifndef DBG_SKIP_MOE
#define DBG_SKIP_MOE 0
#endif
#ifndef DIAG
#define DIAG 0
#endif
#ifndef DIAG_THR
#define DIAG_THR 0.10f
#endif
#ifndef TS_Q
#define TS_Q 70.0f
#endif
#ifndef TS_A0
#define TS_A0 2
#define TS_A1 3
#define TS_B0 3
#define TS_B1 4
#endif
#ifndef DIAG_SUB
#define DIAG_SUB 4
#endif
#ifndef DIAG_STAGE2
#define DIAG_STAGE2 3
#endif
#ifndef DIAG_STAGE
#define DIAG_STAGE 2
#endif
#ifndef P1_FP8
#define P1_FP8 0
#endif
#ifndef P1_MIX
#define P1_MIX 1
#endif
#ifndef N_LAUNCH_MODE
#define N_LAUNCH_MODE 1
#endif

#define LAS __attribute__((address_space(3)))
typedef unsigned short bf16_t;
typedef short bf16x8 __attribute__((ext_vector_type(8)));
typedef float f32x4 __attribute__((ext_vector_type(4)));
typedef unsigned u32x4 __attribute__((ext_vector_type(4)));
typedef unsigned u32x2 __attribute__((ext_vector_type(2)));

constexpr int NT = 16384, DM = 2048, NZ = 20480, SEQ = 4096, NE = 32, DFF = 2048;
constexpr int MAXROWS = 65536 + NE * 256;
constexpr int MAXMT = MAXROWS / 256;
constexpr int NTHREADS = 512;
constexpr float W_SCALE = 1024.0f, X_SCALE = 16.0f, H_SCALE = 4.0f, Y_SCALE = 16.0f;
constexpr int STAGE_LDS = 131072;
constexpr int MIX_LDS = 139776;
constexpr int XTRA_OFF = 152576;
constexpr int LDS_BYTES = XTRA_OFF + 4096;

#define XB_TMO      128
#define XB_XCNT(j)  (256  + 64 * (j))
#define XB_XSUB(j)  (1280 + 64 * (j))
#define XB_XGEN(j)  (2304 + 64 * (j))
#define XB_TOP      3328
#define XB_TOPGEN   3392
#define XCD_BAR_WORDS 3456
#define XB_SPIN_CAP (1u << 22)

__device__ __forceinline__ unsigned xb_ld(unsigned* p)              { return __hip_atomic_load(p, __ATOMIC_RELAXED, __HIP_MEMORY_SCOPE_AGENT); }
__device__ __forceinline__ unsigned xb_add(unsigned* p, unsigned v) { return __hip_atomic_fetch_add(p, v, __ATOMIC_RELAXED, __HIP_MEMORY_SCOPE_AGENT); }
__device__ __forceinline__ unsigned xb_xcc_id() { return (unsigned)__builtin_amdgcn_s_getreg((3 << 11) | 20) & 0xFu; }
#define XB_SPIN(cond, bar) do { unsigned _sp = 0; while (cond) { __builtin_amdgcn_s_sleep(1); \
    if ((++_sp & 255u) == 0u) { if (xb_ld(&(bar)[XB_TMO])) break; if (_sp > XB_SPIN_CAP) { atomicAdd(&(bar)[XB_TMO], 1u); break; } } } } while (0)

struct XcdBarrier { unsigned* bar; unsigned x; volatile LAS unsigned* st; };

__device__ __forceinline__ XcdBarrier xcd_barrier_post(unsigned* bar, volatile LAS unsigned* st) {
    XcdBarrier b; b.bar = bar; b.x = xb_xcc_id(); b.st = st;
    if (threadIdx.x == 0) (void)xb_add(&bar[XB_XCNT(b.x)], 1u);
    return b;
}
__device__ __forceinline__ void xcd_barrier_complete(unsigned* bar, unsigned x, unsigned& nloc, unsigned& nx) {
    const unsigned G = gridDim.x * gridDim.y * gridDim.z;
    unsigned sum, cnt, mine, sp = 0u;
    for (;;) {
        sum = 0u; cnt = 0u; mine = 0u;
#pragma unroll
        for (unsigned j = 0; j < 16; ++j) { const unsigned c = xb_ld(&bar[XB_XCNT(j)]); sum += c; cnt += (c > 0u) ? 1u : 0u; mine = (j == x) ? c : mine; }
        if (sum == G) break;
        __builtin_amdgcn_s_sleep(1);
        if ((++sp & 255u) == 0u) { if (xb_ld(&bar[XB_TMO])) break; if (sp > XB_SPIN_CAP) { atomicAdd(&bar[XB_TMO], 1u); break; } }
    }
    nloc = mine > 0u ? mine : 1u; nx = cnt > 0u ? cnt : 1u;
}
__device__ __forceinline__ void xcd_barrier(const XcdBarrier& b) {
    asm volatile("s_waitcnt vmcnt(0)" ::: "memory");
    __syncthreads();
    if (threadIdx.x == 0) {
        unsigned* bar = b.bar;
        __builtin_amdgcn_s_waitcnt(0);
        unsigned nloc = b.st[0], nx = b.st[1];
        if (nloc == 0u) { xcd_barrier_complete(bar, b.x, nloc, nx); b.st[0] = nloc; b.st[1] = nx; }
        const unsigned old = xb_add(&bar[XB_XSUB(b.x)], 1u);
        const unsigned gen = old / nloc;
        if (old + 1u == (gen + 1u) * nloc) {
            __builtin_amdgcn_fence(__ATOMIC_RELEASE, "agent");
            asm volatile("s_waitcnt vmcnt(0)" ::: "memory");
            const unsigned og = xb_add(&bar[XB_TOP], 1u);
            const unsigned tg = og / nx;
            if (og + 1u == (tg + 1u) * nx) xb_add(&bar[XB_TOPGEN], 1u);
            else XB_SPIN(xb_ld(&bar[XB_TOPGEN]) == tg, bar);
            __builtin_amdgcn_fence(__ATOMIC_ACQUIRE, "agent");
            xb_add(&bar[XB_XGEN(b.x)], 1u);
            asm volatile("s_waitcnt vmcnt(0)" ::: "memory");
        } else {
            XB_SPIN(xb_ld(&bar[XB_XGEN(b.x)]) == gen, bar);
            __builtin_amdgcn_fence(__ATOMIC_ACQUIRE, "agent");
            asm volatile("s_waitcnt vmcnt(0)" ::: "memory");
        }
    }
    __syncthreads();
}

namespace pg8 {
#define PG8_LAS __attribute__((address_space(3)))
constexpr int BM = 256, BK = 64, HALF = 128, HTB = HALF * BK * 2, STAGE_BYTES = 8 * HTB, NXCD = 8, WGM = 8;
__host__ __device__ __forceinline__ int lds_byte(int r, int c) { const int st = (r >> 4) * 2 + (c >> 5), rr = r & 15, cc = c & 31, ob = rr * 64 + cc * 2; return st * 1024 + (ob ^ (((ob >> 9) & 1) << 5)); }
__host__ __device__ __forceinline__ void stage_rc(int b, int& R, int& C) { const int st = b / 1024, sb = b % 1024, swz = sb ^ (((sb >> 9) & 1) << 5); R = (st >> 1) * 16 + swz / 64; C = (st & 1) * 32 + (swz % 64) / 2; }
__host__ __device__ __forceinline__ int perm32(int rho) { const int n = rho >> 4, i = rho & 15; return 8 * (i >> 2) + 4 * n + (i & 3); }
struct Unit { int pm, pn; };
struct Gemm { const bf16_t* A; const bf16_t* Bt; int M, N, K; };
struct StaticOrder {
    int nM, nN, nwg, G, c;
    __host__ __device__ void init(int M, int N, int G_, int c_) { nM = M / BM; nN = N / BM; nwg = nM * nN; G = G_; c = c_; }
    __host__ __device__ bool next(int i, Unit& u) const {
        const long L = (long)i * G + c; if (L >= nwg) return false;
        int wgid = (int)L; { const int q = nwg / NXCD, r = nwg % NXCD, xcd = wgid % NXCD, off = wgid / NXCD; wgid = (xcd < r ? xcd * (q + 1) : r * (q + 1) + (xcd - r) * q) + off; }
        const int nig = WGM * nN, gid = wgid / nig, fm = gid * WGM, gsz = (nM - fm) < WGM ? (nM - fm) : WGM;
        u.pm = fm + ((wgid % nig) % gsz); u.pn = (wgid % nig) / gsz; return true;
    }
    __device__ __forceinline__ void a_ready(const Unit&) const {}
    __device__ __forceinline__ void done(const Unit&) const {}
    static constexpr bool GATHER = false; const int* rowtok;
};
typedef int i32x8 __attribute__((ext_vector_type(8)));
typedef int i32x4 __attribute__((ext_vector_type(4)));
__device__ __forceinline__ i32x8 cat8(bf16x8 a, bf16x8 b) { return __builtin_shufflevector(__builtin_bit_cast(i32x4, a), __builtin_bit_cast(i32x4, b), 0, 1, 2, 3, 4, 5, 6, 7); }
__device__ __forceinline__ unsigned cvt_pk_bf16(float lo, float hi) { unsigned r; asm volatile("v_cvt_pk_bf16_f32 %0, %1, %2" : "=v"(r) : "v"(lo), "v"(hi)); return r; }

template <class Epi, class Sched>
__device__ __forceinline__ void gemm_phase(PG8_LAS unsigned char* lds, const Gemm g, const Sched& S, const Epi& E) {
    const int tid = threadIdx.x, wid = __builtin_amdgcn_readfirstlane(tid >> 6), lane = tid & 63, wr = wid >> 2, wc = wid & 3, fr = lane & 15, fq = lane >> 4;
    const int K = g.K, nt = K / BK;
    unsigned voffA[2], voffB[2];
#pragma unroll
    for (int i = 0; i < 2; ++i) { int R, C; stage_rc(tid * 16 + i * 8192, R, C); const int Rb = Epi::PERM ? ((R & ~31) + perm32(R & 31)) : R;
        voffA[i] = (unsigned)(R * K + C) * 2u; voffB[i] = (unsigned)(Rb * K + C) * 2u; }
    constexpr bool GA = Sched::GATHER;
    unsigned vgC0[2] = {0u, 0u}, vgC1[2] = {0u, 0u}, vgN0[2] = {0u, 0u}, vgN1[2] = {0u, 0u};
#define PG8_GOFF(U, d0, d1) do { _Pragma("unroll") for (int _i = 0; _i < 2; ++_i) { int _R, _C; stage_rc(tid * 16 + _i * 8192, _R, _C); const int _b = (U).pm * 256 + _R; \
        d0[_i] = (unsigned)S.rowtok[_b] * (unsigned)(K * 2) + (unsigned)(_C * 2); d1[_i] = (unsigned)S.rowtok[_b + 128] * (unsigned)(K * 2) + (unsigned)(_C * 2); } } while (0)
#define PG8_STAGE_A(bufoff, gbase, H, o0, o1) do { if constexpr (GA) { if (H) PG8_STAGE(bufoff, gbase, o1); else PG8_STAGE(bufoff, gbase, o0); } \
        else { PG8_STAGE(bufoff, (gbase) + ((H) ? hstep : (size_t)0), voffA); } } while (0)
    const size_t kstep = (size_t)(BK * 2);
    const size_t hstep = (size_t)HALF * K * 2;
    const size_t tstep = 2 * hstep;
    const unsigned ldsw = (unsigned)wid * 1024u;
    const int aoff = lds_byte(wr * 64 + fr, fq * 8), boff = lds_byte(wc * 32 + fr, fq * 8);
#define PG8_SA(b, h) (((b) * 2 + (h)) * HTB)
#define PG8_SB(b, h) ((4 + (b) * 2 + (h)) * HTB)
#define PG8_STAGE(bufoff, gbase, voff) do { _Pragma("unroll") for (int _i = 0; _i < 2; ++_i) \
        __builtin_amdgcn_global_load_lds((const unsigned*)((const char*)(gbase) + (voff)[_i]), (PG8_LAS unsigned*)(lds + (bufoff) + ldsw + _i * 8192), 16, 0, 0); } while (0)
#define PG8_LDA(dst, b, h) do { _Pragma("unroll") for (int m = 0; m < 4; ++m) { \
        if constexpr (Epi::FP8) { const i32x4 _lo = *(const PG8_LAS i32x4*)(lds + PG8_SA(b, h) + aoff + m * 2048), _hi = *(const PG8_LAS i32x4*)(lds + PG8_SA(b, h) + aoff + m * 2048 + 1024); dst##8[m] = __builtin_shufflevector(_lo, _hi, 0, 1, 2, 3, 4, 5, 6, 7); } \
        else { _Pragma("unroll") for (int k = 0; k < 2; ++k) dst[m][k] = *(const PG8_LAS bf16x8*)(lds + PG8_SA(b, h) + aoff + m * 2048 + k * 1024); } } } while (0)
#define PG8_LDB(dst, b, h) do { _Pragma("unroll") for (int n = 0; n < 2; ++n) { \
        if constexpr (Epi::FP8) { const i32x4 _lo = *(const PG8_LAS i32x4*)(lds + PG8_SB(b, h) + boff + n * 2048), _hi = *(const PG8_LAS i32x4*)(lds + PG8_SB(b, h) + boff + n * 2048 + 1024); dst##8[n] = __builtin_shufflevector(_lo, _hi, 0, 1, 2, 3, 4, 5, 6, 7); } \
        else { _Pragma("unroll") for (int k = 0; k < 2; ++k) dst[n][k] = *(const PG8_LAS bf16x8*)(lds + PG8_SB(b, h) + boff + n * 2048 + k * 1024); } } } while (0)
#define PG8_MMA(ai, bj, At, Bt) do { __builtin_amdgcn_s_setprio(1); _Pragma("unroll") for (int m = 0; m < 4; ++m) _Pragma("unroll") for (int n = 0; n < 2; ++n) { \
        if constexpr (Epi::FP8) { asm volatile("v_mfma_scale_f32_16x16x128_f8f6f4 %0, %1, %2, %0, %3, %3 op_sel_hi:[0,0,0]" : "+v"(acc[ai][bj][m][n]) : "v"(Bt##8[n]), "v"(At##8[m]), "v"(f8scale)); } \
        else { _Pragma("unroll") for (int k = 0; k < 2; ++k) acc[ai][bj][m][n] = __builtin_amdgcn_mfma_f32_16x16x32_bf16(Bt[n][k], At[m][k], acc[ai][bj][m][n], 0, 0, 0); } } \
        __builtin_amdgcn_s_setprio(0); } while (0)
#define PG8_WAIT_V(n) asm volatile("s_waitcnt vmcnt(" #n ")" ::: "memory")
#define PG8_WAIT_L(n) asm volatile("s_waitcnt lgkmcnt(" #n ")" ::: "memory")
#define PG8_BAR __builtin_amdgcn_s_barrier()
#define PG8_SCHED __builtin_amdgcn_sched_barrier(0)
    Unit cur, nxt; int ui = 0;
    if (!S.next(0, cur)) return;
    f32x4 acc[2][2][4][2];
#pragma unroll
    for (int a = 0; a < 2; ++a)
#pragma unroll
        for (int b = 0; b < 2; ++b)
#pragma unroll
            for (int m = 0; m < 4; ++m)
#pragma unroll
                for (int n = 0; n < 2; ++n) acc[a][b][m][n] = (f32x4){0.f, 0.f, 0.f, 0.f};
    bf16x8 At[4][2], B0[2][2], B1[2][2];
    i32x8 At8[4], B08[2], B18[2];
    const int f8scale = 0x7F7F7F7F;
    const char* cA = (const char*)g.A + (GA ? (size_t)0 : (size_t)cur.pm * tstep); const char* cB = (const char*)g.Bt + (size_t)cur.pn * tstep;
    S.a_ready(cur);
    if constexpr (GA) { PG8_GOFF(cur, vgC0, vgC1); vgN0[0] = vgC0[0]; vgN0[1] = vgC0[1]; vgN1[0] = vgC1[0]; vgN1[1] = vgC1[1]; }
    PG8_STAGE(PG8_SB(0, 0), cB, voffB); PG8_STAGE_A(PG8_SA(0, 0), cA, 0, vgC0, vgC1); PG8_STAGE(PG8_SB(0, 1), cB + hstep, voffB); PG8_STAGE_A(PG8_SA(0, 1), cA, 1, vgC0, vgC1);
    if (wr == 1) PG8_BAR;
    PG8_WAIT_V(4); PG8_BAR;
    PG8_STAGE(PG8_SB(1, 0), cB + kstep, voffB); PG8_STAGE_A(PG8_SA(1, 0), cA + kstep, 0, vgC0, vgC1); PG8_STAGE(PG8_SB(1, 1), cB + hstep + kstep, voffB);
    PG8_WAIT_V(6); PG8_BAR;
    for (;;) {
        const bool has_next = S.next(ui + 1, nxt);
        const char* nA = (has_next && !GA) ? (const char*)g.A + (size_t)nxt.pm * tstep : cA; const char* nB = has_next ? (const char*)g.Bt + (size_t)nxt.pn * tstep : cB;
        for (int t = 0; t < nt; t += 2) {
            const bool last = (t == nt - 2);
            const char* a1 = cA + (size_t)(t + 1) * kstep;
            const char* a2 = last ? nA : cA + (size_t)(t + 2) * kstep; const char* b2 = last ? nB : cB + (size_t)(t + 2) * kstep;
            const char* a3 = a2 + kstep; const char* b3 = b2 + kstep;
            if (last && has_next) S.a_ready(nxt);
            unsigned s0[2] = {0u, 0u}, s1[2] = {0u, 0u};
            if constexpr (GA) { if (last && has_next) PG8_GOFF(nxt, vgN0, vgN1);
                s0[0] = last ? vgN0[0] : vgC0[0]; s0[1] = last ? vgN0[1] : vgC0[1]; s1[0] = last ? vgN1[0] : vgC1[0]; s1[1] = last ? vgN1[1] : vgC1[1]; }
            PG8_LDB(B0, 0, 0); PG8_SCHED; PG8_LDA(At, 0, 0); PG8_STAGE_A(PG8_SA(1, 1), a1, 1, vgC0, vgC1);
            PG8_WAIT_L(8); PG8_BAR; PG8_WAIT_L(0); PG8_MMA(0, 0, At, B0); PG8_BAR; PG8_SCHED;
            PG8_LDB(B1, 0, 1); PG8_STAGE(PG8_SB(0, 0), b2, voffB);
            PG8_BAR; PG8_WAIT_L(0); PG8_MMA(0, 1, At, B1); PG8_BAR;
            PG8_LDA(At, 0, 1); PG8_STAGE_A(PG8_SA(0, 0), a2, 0, s0, s1);
            PG8_BAR; PG8_WAIT_L(0); PG8_MMA(1, 0, At, B0); PG8_BAR; PG8_SCHED;
            PG8_STAGE(PG8_SB(0, 1), b2 + hstep, voffB);
            PG8_WAIT_V(6); PG8_BAR; PG8_MMA(1, 1, At, B1); PG8_BAR;
            PG8_LDB(B0, 1, 0); PG8_SCHED; PG8_LDA(At, 1, 0); PG8_STAGE_A(PG8_SA(0, 1), a2, 1, s0, s1);
            PG8_WAIT_L(8); PG8_BAR; PG8_WAIT_L(0); PG8_MMA(0, 0, At, B0); PG8_BAR; PG8_SCHED;
            PG8_LDB(B1, 1, 1); PG8_STAGE(PG8_SB(1, 0), b3, voffB);
            PG8_BAR; PG8_WAIT_L(0); PG8_MMA(0, 1, At, B1); PG8_BAR;
            PG8_LDA(At, 1, 1); PG8_STAGE_A(PG8_SA(1, 0), a3, 0, s0, s1);
            PG8_BAR; PG8_WAIT_L(0); PG8_MMA(1, 0, At, B0); PG8_BAR; PG8_SCHED;
            PG8_STAGE(PG8_SB(1, 1), b3 + hstep, voffB);
            PG8_WAIT_V(6); PG8_BAR; PG8_MMA(1, 1, At, B1); PG8_BAR;
        }
        if constexpr (Epi::FP8) asm volatile("s_nop 15\n\ts_nop 15" ::: "memory");
        E(acc, cur, wr, wc, fr, fq); S.done(cur);
        if (!has_next) break;
#pragma unroll
        for (int a = 0; a < 2; ++a)
#pragma unroll
            for (int b = 0; b < 2; ++b)
#pragma unroll
                for (int m = 0; m < 4; ++m)
#pragma unroll
                    for (int n = 0; n < 2; ++n) acc[a][b][m][n] = (f32x4){0.f, 0.f, 0.f, 0.f};
        cur = nxt; cA = nA; cB = nB; ++ui;
        if constexpr (GA) { vgC0[0] = vgN0[0]; vgC0[1] = vgN0[1]; vgC1[0] = vgN1[0]; vgC1[1] = vgN1[1]; }
    }
    PG8_WAIT_V(0);
    if (wr == 0) PG8_BAR;
    PG8_BAR;
#undef PG8_SA
#undef PG8_SB
#undef PG8_STAGE
#undef PG8_STAGE_A
#undef PG8_GOFF
#undef PG8_LDA
#undef PG8_LDB
#undef PG8_MMA
#undef PG8_WAIT_V
#undef PG8_WAIT_L
#undef PG8_BAR
#undef PG8_SCHED
}
}

struct Params {
    const float *x, *w_in, *ret_nw, *hg_nw, *lb_logits, *w_out, *nmix_w, *nmoe_w, *w_router, *b_router, *w1, *b1, *w2, *b2, *nfin_w;
    float* out;
    bf16_t *hn8, *w_in_t8, *gz; bf16_t *w_in_t, *w_out_t, *w1t, *w2t, *hn, *z, *merged, *hn2, *xg, *hid, *y;
    bf16_t *o_r, *o_h, *h2b; float *h2, *cosT, *sinT, *b1p, *tk_g, *row_gate, *e63;
    bf16_t* k2t; bf16_t* dz; bf16_t *pr, *ph, *kt, *wr_hi, *wr_lo;
    void* pad1;
    int *gcnt, *tk_e, *tk_rank, *pos, *whist;
    float* diag;
    unsigned* bar;
    long long lo_hi;
};

__device__ __forceinline__ float bf2f(unsigned short b) { return __uint_as_float(((unsigned)b) << 16); }
typedef __bf16 bf16v2_t __attribute__((ext_vector_type(2)));
typedef float f32x2_t __attribute__((ext_vector_type(2)));
__device__ __forceinline__ unsigned cvt2(float lo, float hi) { const bf16v2_t r = __builtin_convertvector((f32x2_t){lo, hi}, bf16v2_t); return __builtin_bit_cast(unsigned, r); }
__device__ __forceinline__ unsigned short f2bf(float f) { return (unsigned short)(cvt2(f, 0.f) & 0xffffu); }
__device__ __forceinline__ unsigned cvt4_fp8(float a, float b, float c, float d) {
    a = __builtin_amdgcn_fmed3f(a, -448.f, 448.f); b = __builtin_amdgcn_fmed3f(b, -448.f, 448.f); c = __builtin_amdgcn_fmed3f(c, -448.f, 448.f); d = __builtin_amdgcn_fmed3f(d, -448.f, 448.f);
    int w = 0; w = __builtin_amdgcn_cvt_pk_fp8_f32(a, b, w, false); w = __builtin_amdgcn_cvt_pk_fp8_f32(c, d, w, true); return (unsigned)w;
}
__device__ __forceinline__ float fp8_to_f32(unsigned b) {
    const unsigned sg = (b >> 7) & 1u, ex = (b >> 3) & 15u, mn = b & 7u;
    float v = (ex == 0u) ? (float)mn * 0.001953125f : (1.0f + (float)mn * 0.125f) * exp2f((float)ex - 7.0f);
    return sg ? -v : v;
}
template <int MAP> __host__ __device__ __forceinline__ int p1_tile(int c) { return MAP == 1 ? (c < 24 ? c : c + 8) : MAP == 2 ? (c < 8 ? 24 + c : 48 + c) : c; }
template <int CMAP> __host__ __device__ __forceinline__ int p1_src_col(int ct, int c) {
    if (CMAP == 2) { const int t = ct & 15, base = (ct < 16) ? (c < 128 ? 6144 : 16384) : (c < 128 ? 14336 : 18432); return base + 128 * t + (c & 127); }
    return p1_tile<CMAP>(ct) * 256 + c;
}
__device__ __forceinline__ float wave_sum(float v) {
#pragma unroll
    for (int o = 32; o >= 1; o >>= 1) v += __shfl_xor(v, o);
    return v;
}
__device__ __forceinline__ float sigmoidf_(float x) { return __builtin_amdgcn_rcpf(1.0f + __expf(-x)); }
__device__ __forceinline__ float ex2_(float x) { return __builtin_amdgcn_exp2f(x); }
__device__ __forceinline__ float lg2_(float x) { return __builtin_amdgcn_logf(x); }
__device__ __forceinline__ f32x4 mma16(bf16x8 a, bf16x8 b, f32x4 c) { return __builtin_amdgcn_mfma_f32_16x16x32_bf16(a, b, c, 0, 0, 0); }
__device__ __forceinline__ bf16x8 ldfrag(const LAS bf16_t* base, int ld, int r0, int k0, int lane) {
    return *(const LAS bf16x8*)(base + (r0 + (lane & 15)) * ld + k0 + (lane >> 4) * 8);
}

template <int MODE>
__device__ __forceinline__ void tr_tile8(const float* src, int ldsrc, unsigned char* dst, int lddst, int k0, int c0, LAS float* tl, float scale) {
    const int t = threadIdx.x;
    {
        const int c = t & 63, r0 = t >> 6;
#pragma unroll
        for (int i = 0; i < 8; ++i) tl[(r0 + 8 * i) * 65 + c] = src[(size_t)(k0 + r0 + 8 * i) * ldsrc + c0 + c];
    }
    __syncthreads();
    {
        const int cl = t >> 3, ko = (t & 7) * 8;
        float v[8];
#pragma unroll
        for (int j = 0; j < 8; ++j) v[j] = tl[(ko + j) * 65 + cl] * scale;
        const int col = c0 + cl;
        int drow = col;
        if (MODE == 1) { const int j = col >> 1, lin = col & 1; drow = (j >> 7) * 256 + lin * 128 + (j & 127); }
        u32x2 w; w.x = cvt4_fp8(v[0], v[1], v[2], v[3]); w.y = cvt4_fp8(v[4], v[5], v[6], v[7]);
        *(u32x2*)(dst + (size_t)drow * lddst + k0 + ko) = w;
    }
    __syncthreads();
}
template <int MODE>
__device__ __forceinline__ void tr_tile(const float* src, int ldsrc, bf16_t* dst, int lddst, int k0, int c0, LAS float* tl) {
    const int t = threadIdx.x;
    {
        const int c = t & 63, r0 = t >> 6;
#pragma unroll
        for (int i = 0; i < 8; ++i) tl[(r0 + 8 * i) * 65 + c] = src[(size_t)(k0 + r0 + 8 * i) * ldsrc + c0 + c];
    }
    __syncthreads();
    {
        const int cl = t >> 3, ko = (t & 7) * 8;
        float v[8];
#pragma unroll
        for (int j = 0; j < 8; ++j) v[j] = tl[(ko + j) * 65 + cl];
        const int col = c0 + cl;
        int drow = col;
        if (MODE == 1) { const int j = col >> 1, lin = col & 1; drow = (j >> 7) * 256 + lin * 128 + (j & 127); }
        u32x4 w; w.x = cvt2(v[0], v[1]); w.y = cvt2(v[2], v[3]); w.z = cvt2(v[4], v[5]); w.w = cvt2(v[6], v[7]);
        *(u32x4*)(dst + (size_t)drow * lddst + k0 + ko) = w;
    }
    __syncthreads();
}


template <int MODE, bool F8, int CMAP = 0>
__device__ __forceinline__ void convert_tensor(const float* src, int ldsrc, void* dst, int lddst, int nKt, int nCt, int nE, size_t srcE, size_t dstE, LAS float* tl, int bid, int nb, float scale) {
    const int tid = threadIdx.x, r0 = tid >> 6, c4 = (tid & 63) * 4, col = tid & 255, kh = tid >> 8;
    const int per = nKt * nCt, total = nE * per;
    f32x4 cur[8], nxt[8];
    int t = bid;
#define CT_LOAD(dstv, tt) do { const int _e = (tt) / per, _r = (tt) % per, _kt = _r / nCt, _ct = _r % nCt; \
        const float* _sp = src + (size_t)_e * srcE + (size_t)(_kt * 64 + r0) * ldsrc + p1_src_col<CMAP>(_ct, c4); \
        _Pragma("unroll") for (int i = 0; i < 8; ++i) dstv[i] = *(const f32x4*)(_sp + (size_t)(8 * i) * ldsrc); } while (0)
    if (t < total) CT_LOAD(cur, t);
    for (; t < total; t += nb) {
        const int tn = (t + nb < total) ? t + nb : t;
        CT_LOAD(nxt, tn);
        __builtin_amdgcn_sched_barrier(0);
#pragma unroll
        for (int i = 0; i < 8; ++i) *(LAS f32x4*)(tl + (r0 + 8 * i) * 260 + c4) = cur[i];
        __syncthreads();
        {
            const int e = t / per, r = t % per, kt = r / nCt, ct = r % nCt;
            const int gcol = ct * 256 + col;
            int drow = gcol;
            if (MODE == 1) { const int j = gcol >> 1, lin = gcol & 1; drow = (j >> 7) * 256 + lin * 128 + (j & 127); }
            float v[32];
#pragma unroll
            for (int j = 0; j < 32; ++j) v[j] = tl[(kh * 32 + j) * 260 + col] * scale;
            if (F8) {
                unsigned char* dp = (unsigned char*)dst + (size_t)e * dstE + (size_t)drow * lddst + kt * 64 + kh * 32;
                u32x4 w0, w1;
                w0.x = cvt4_fp8(v[0], v[1], v[2], v[3]); w0.y = cvt4_fp8(v[4], v[5], v[6], v[7]); w0.z = cvt4_fp8(v[8], v[9], v[10], v[11]); w0.w = cvt4_fp8(v[12], v[13], v[14], v[15]);
                w1.x = cvt4_fp8(v[16], v[17], v[18], v[19]); w1.y = cvt4_fp8(v[20], v[21], v[22], v[23]); w1.z = cvt4_fp8(v[24], v[25], v[26], v[27]); w1.w = cvt4_fp8(v[28], v[29], v[30], v[31]);
                *(u32x4*)(dp) = w0; *(u32x4*)(dp + 16) = w1;
            } else {
                bf16_t* dp = (bf16_t*)dst + (size_t)e * dstE + (size_t)drow * lddst + kt * 64 + kh * 32;
#pragma unroll
                for (int q = 0; q < 4; ++q) { u32x4 w; w.x = cvt2(v[8 * q], v[8 * q + 1]); w.y = cvt2(v[8 * q + 2], v[8 * q + 3]); w.z = cvt2(v[8 * q + 4], v[8 * q + 5]); w.w = cvt2(v[8 * q + 6], v[8 * q + 7]); *(u32x4*)(dp + 8 * q) = w; }
            }
        }
        __syncthreads();
        __builtin_amdgcn_sched_barrier(0);
#pragma unroll
        for (int i = 0; i < 8; ++i) cur[i] = nxt[i];
    }
#undef CT_LOAD
}

__device__ __forceinline__ void rms_rows_to_bf16(const float* src, const float* w, bf16_t* dst, int bid, int nb) {
    const int lane = threadIdx.x & 63, wid = threadIdx.x >> 6;
    for (int row = bid * 8 + wid; row < NT; row += nb * 8) {
        const f32x4* xr = (const f32x4*)(src + (size_t)row * DM);
        f32x4 v[8]; float ss = 0.f;
#pragma unroll
        for (int i = 0; i < 8; ++i) { v[i] = xr[i * 64 + lane]; ss += v[i][0] * v[i][0] + v[i][1] * v[i][1] + v[i][2] * v[i][2] + v[i][3] * v[i][3]; }
        ss = wave_sum(ss);
        const float rstd = rsqrtf(ss * (1.0f / DM) + 1e-6f);
#pragma unroll
        for (int i = 0; i < 8; ++i) {
            const f32x4 wv = ((const f32x4*)w)[i * 64 + lane];
            u32x2 o; o.x = cvt2(v[i][0] * rstd * wv[0], v[i][1] * rstd * wv[1]); o.y = cvt2(v[i][2] * rstd * wv[2], v[i][3] * rstd * wv[3]);
            *(u32x2*)(dst + (size_t)row * DM + (i * 64 + lane) * 4) = o;
        }
    }
}

__device__ __forceinline__ void rms_rows_to_both(const float* src, const float* w, bf16_t* dst, unsigned char* dst8, int bid, int nb) {
    const int lane = threadIdx.x & 63, wid = threadIdx.x >> 6;
    for (int row = bid * 8 + wid; row < NT; row += nb * 8) {
        const f32x4* xr = (const f32x4*)(src + (size_t)row * DM);
        f32x4 v[8]; float ss = 0.f;
#pragma unroll
        for (int i = 0; i < 8; ++i) { v[i] = xr[i * 64 + lane]; ss += v[i][0] * v[i][0] + v[i][1] * v[i][1] + v[i][2] * v[i][2] + v[i][3] * v[i][3]; }
        ss = wave_sum(ss);
        const float rstd = rsqrtf(ss * (1.0f / DM) + 1e-6f);
#pragma unroll
        for (int i = 0; i < 8; ++i) {
            const f32x4 wv = ((const f32x4*)w)[i * 64 + lane];
            const f32x4 o = v[i] * rstd * wv;
            u32x2 ob; ob.x = cvt2(o[0], o[1]); ob.y = cvt2(o[2], o[3]);
            *(u32x2*)(dst + (size_t)row * DM + (i * 64 + lane) * 4) = ob;
            *(unsigned*)(dst8 + (size_t)row * DM + (i * 64 + lane) * 4) = cvt4_fp8(o[0] * X_SCALE, o[1] * X_SCALE, o[2] * X_SCALE, o[3] * X_SCALE);
        }
    }
}
__device__ __forceinline__ void rms_rows_to_fp8(const float* src, const float* w, unsigned char* dst, int bid, int nb) {
    const int lane = threadIdx.x & 63, wid = threadIdx.x >> 6;
    for (int row = bid * 8 + wid; row < NT; row += nb * 8) {
        const f32x4* xr = (const f32x4*)(src + (size_t)row * DM);
        f32x4 v[8]; float ss = 0.f;
#pragma unroll
        for (int i = 0; i < 8; ++i) { v[i] = xr[i * 64 + lane]; ss += v[i][0] * v[i][0] + v[i][1] * v[i][1] + v[i][2] * v[i][2] + v[i][3] * v[i][3]; }
        ss = wave_sum(ss);
        const float rstd = rsqrtf(ss * (1.0f / DM) + 1e-6f) * X_SCALE;
#pragma unroll
        for (int i = 0; i < 8; ++i) {
            const f32x4 wv = ((const f32x4*)w)[i * 64 + lane];
            *(unsigned*)(dst + (size_t)row * DM + (i * 64 + lane) * 4) = cvt4_fp8(v[i][0] * rstd * wv[0], v[i][1] * rstd * wv[1], v[i][2] * rstd * wv[2], v[i][3] * rstd * wv[3]);
        }
    }
}
__device__ __forceinline__ void p0_prologue(const Params& p, LAS unsigned char* lds, int bid, int nb) {
    LAS float* tl = (LAS float*)lds;
    const int tid = threadIdx.x;
    for (int i = bid * NTHREADS + tid; i < SEQ * 128; i += nb * NTHREADS) {
        const int s = i >> 7, pr = i & 127;
        const float inv = exp2f(-(float)pr * (13.287712379549449f / 127.0f));
        const double rev = (double)s * (double)inv * 0.15915494309189535;
        const float fr = (float)(rev - floor(rev));
        p.cosT[i] = __builtin_amdgcn_cosf(fr); p.sinT[i] = __builtin_amdgcn_sinf(fr);
    }
    for (int i = bid * NTHREADS + tid; i < NE * DM; i += nb * NTHREADS) {
        const int e = i >> 11, k = i & 2047; const float v = p.w_router[(size_t)k * NE + e];
        const bf16_t hi = f2bf(v); p.wr_hi[i] = hi; p.wr_lo[i] = f2bf(v - bf2f(hi));
    }
    for (int i = bid * NTHREADS + tid; i < NE * 4096; i += nb * NTHREADS) {
        const int e = i >> 12, np = i & 4095, pn = np >> 8, cl = np & 255, j = pn * 128 + (cl & 127);
        p.b1p[i] = p.b1[e * 4096 + 2 * j + (cl >> 7)];
    }
#if P1_MIX
    rms_rows_to_both(p.x, p.nmix_w, p.hn, (unsigned char*)p.hn8, bid, nb);
#else
    if (P1_FP8) rms_rows_to_fp8(p.x, p.nmix_w, (unsigned char*)p.hn, bid, nb); else rms_rows_to_bf16(p.x, p.nmix_w, p.hn, bid, nb);
#endif
    __syncthreads();
#if P1_MIX
    convert_tensor<0, false, 1>(p.w_in, NZ, p.w_in_t, DM, 32, 48, 1, 0, 0, tl, bid, nb, 1.0f);
    convert_tensor<0, true, 2>(p.w_in, NZ, p.w_in_t8, DM, 32, 32, 1, 0, 0, tl, bid, nb, W_SCALE);
#else
    if (P1_FP8) convert_tensor<0, true>(p.w_in, NZ, p.w_in_t, DM, 32, NZ / 256, 1, 0, 0, tl, bid, nb, W_SCALE);
    else convert_tensor<0, false>(p.w_in, NZ, p.w_in_t, DM, 32, NZ / 256, 1, 0, 0, tl, bid, nb, 1.0f);
#endif
    convert_tensor<0, false>(p.w_out, DM, p.w_out_t, DM, 32, DM / 256, 1, 0, 0, tl, bid, nb, 1.0f);
    if (nb != 256) convert_tensor<1, true>(p.w1, 4096, p.w1t, DM, 32, 16, NE, (size_t)DM * 4096, (size_t)4096 * DM, tl, bid, nb, W_SCALE);
    if (nb == 256) convert_tensor<0, true>(p.w2 + (size_t)16 * DFF * DM, DM, (unsigned char*)p.w2t + (size_t)16 * DM * DFF, DFF, 32, 8, 16, (size_t)DFF * DM, (size_t)DM * DFF, tl, bid, nb, W_SCALE);
    else convert_tensor<0, true>(p.w2, DM, p.w2t, DFF, 32, 8, NE, (size_t)DFF * DM, (size_t)DM * DFF, tl, bid, nb, W_SCALE);
}

template <bool F8, int MAP>
struct EpiZT {
    static constexpr bool PERM = true, AFTER_DRAIN = false, FP8 = F8;
    bf16_t* Z; const float* cosT; const float* sinT;
    __device__ __forceinline__ void operator()(const f32x4 (&acc)[2][2][4][2], const pg8::Unit& u, int wr, int wc, int fr, int fq) const {
        const int pn = p1_tile<MAP>(u.pn);
        const int row0 = u.pm * 256 + wr * 64 + fr, pc = wc * 32 + 8 * fq, col0 = pn * 256 + pc;
        const bool rot = pn < 16; const float sc = (pn >= 8 && pn < 16) ? 0.0625f : 1.0f;
#pragma unroll
        for (int ai = 0; ai < 2; ++ai)
#pragma unroll
            for (int m = 0; m < 4; ++m) {
                const int row = row0 + ai * 128 + m * 16;
                constexpr float dqz = FP8 ? 1.0f / (W_SCALE * X_SCALE) : 1.0f;
                f32x4 a0 = acc[ai][0][m][0] * dqz, a1 = acc[ai][0][m][1] * dqz, b0 = acc[ai][1][m][0] * dqz, b1 = acc[ai][1][m][1] * dqz;
                if (rot) {
                    const int s = row & (SEQ - 1);
                    const f32x4 c0 = *(const f32x4*)(cosT + s * 128 + pc), c1 = *(const f32x4*)(cosT + s * 128 + pc + 4);
                    const f32x4 s0 = *(const f32x4*)(sinT + s * 128 + pc), s1 = *(const f32x4*)(sinT + s * 128 + pc + 4);
                    const f32x4 na0 = (a0 * c0 - b0 * s0) * sc, na1 = (a1 * c1 - b1 * s1) * sc;
                    const f32x4 nb0 = (b0 * c0 + a0 * s0) * sc, nb1 = (b1 * c1 + a1 * s1) * sc;
                    a0 = na0; a1 = na1; b0 = nb0; b1 = nb1;
                }
                bf16_t* rowp = Z + (size_t)row * NZ + col0;
                u32x4 w; w.x = cvt2(a0[0], a0[1]); w.y = cvt2(a0[2], a0[3]); w.z = cvt2(a1[0], a1[1]); w.w = cvt2(a1[2], a1[3]);
                *(u32x4*)(rowp) = w;
                u32x4 v; v.x = cvt2(b0[0], b0[1]); v.y = cvt2(b0[2], b0[3]); v.z = cvt2(b1[0], b1[1]); v.w = cvt2(b1[2], b1[3]);
                *(u32x4*)(rowp + 128) = v;
            }
    }
};
struct EpiGate {
    static constexpr bool PERM = true, AFTER_DRAIN = false, FP8 = true;
    bf16_t* G;
    __device__ __forceinline__ void operator()(const f32x4 (&acc)[2][2][4][2], const pg8::Unit& u, int wr, int wc, int fr, int fq) const {
        const int row0 = u.pm * 256 + wr * 64 + fr, col0 = u.pn * 128 + wc * 32 + 8 * fq;
        typedef float f2 __attribute__((ext_vector_type(2)));
        float dqv = 1.0f / (W_SCALE * X_SCALE), ndv = -1.4426950408889634f / (W_SCALE * X_SCALE); asm volatile("" : "+s"(dqv), "+s"(ndv));
        const f2 dq2 = (f2){dqv, dqv}, nd2 = (f2){ndv, ndv}, one2 = (f2){1.0f, 1.0f};
#pragma unroll
        for (int ai = 0; ai < 2; ++ai)
#pragma unroll
            for (int m = 0; m < 4; ++m) {
                const int row = row0 + ai * 128 + m * 16;
                float o[8];
#pragma unroll
                for (int n = 0; n < 2; ++n)
#pragma unroll
                    for (int i = 0; i < 4; i += 2) {
                        const f2 a = (f2){acc[ai][0][m][n][i], acc[ai][0][m][n][i + 1]}, b = (f2){acc[ai][1][m][n][i], acc[ai][1][m][n][i + 1]};
                        const f2 ta = a * nd2, tb = b * nd2;
                        f2 t; t.x = ex2_(ta.x); t.y = ex2_(ta.y); t = t + one2;
                        f2 eb; eb.x = ex2_(tb.x); eb.y = ex2_(tb.y);
                        const f2 den = eb * t + t;
                        f2 r; r.x = __builtin_amdgcn_rcpf(den.x); r.y = __builtin_amdgcn_rcpf(den.y);
                        const f2 g = (a * dq2) * r; o[4 * n + i] = g.x; o[4 * n + i + 1] = g.y; }
                u32x4 w; w.x = cvt2(o[0], o[1]); w.y = cvt2(o[2], o[3]); w.z = cvt2(o[4], o[5]); w.w = cvt2(o[6], o[7]);
                *(u32x4*)(G + (size_t)row * 4096 + col0) = w;
            }
    }
};
struct EpiRes {
    static constexpr bool PERM = true, AFTER_DRAIN = false, FP8 = false;
    bf16_t* C; const float* R;
    __device__ __forceinline__ void operator()(const f32x4 (&acc)[2][2][4][2], const pg8::Unit& u, int wr, int wc, int fr, int fq) const {
        const int row0 = u.pm * 256 + wr * 64 + fr, col0 = u.pn * 256 + wc * 32 + 8 * fq;
#pragma unroll
        for (int ai = 0; ai < 2; ++ai)
#pragma unroll
            for (int m = 0; m < 4; ++m) {
                const size_t ro = (size_t)(row0 + ai * 128 + m * 16) * DM + col0;
#pragma unroll
                for (int bj = 0; bj < 2; ++bj) {
                    const f32x4 r0 = *(const f32x4*)(R + ro + bj * 128), r1 = *(const f32x4*)(R + ro + bj * 128 + 4);
                    const f32x4 v0 = acc[ai][bj][m][0] + r0, v1 = acc[ai][bj][m][1] + r1;
                    u32x4 w; w.x = cvt2(v0[0], v0[1]); w.y = cvt2(v0[2], v0[3]); w.z = cvt2(v1[0], v1[1]); w.w = cvt2(v1[2], v1[3]);
                    *(u32x4*)(C + ro + bj * 128) = w;
                }
            }
    }
};
struct EpiSwiglu {
    static constexpr bool PERM = true, AFTER_DRAIN = false, FP8 = true;
    unsigned char* H; const float* b1p;
    typedef float f2 __attribute__((ext_vector_type(2)));
    static __device__ __forceinline__ f2 act2(f2 ag, f2 al, f2 bg, f2 bl, f2 dq2) {
        const f2 g = ag * dq2 + bg, l = al * dq2 + bl;
        f2 xg, xl; xg.x = fminf(g.x, 7.0f); xg.y = fminf(g.y, 7.0f);
        xl.x = __builtin_amdgcn_fmed3f(l.x, -7.0f, 7.0f); xl.y = __builtin_amdgcn_fmed3f(l.y, -7.0f, 7.0f);
        const f2 t = xg * (f2){-1.702f * 1.4426950408889634f, -1.702f * 1.4426950408889634f};
        f2 d; d.x = ex2_(t.x); d.y = ex2_(t.y); d = d + (f2){1.0f, 1.0f};
        f2 r; r.x = __builtin_amdgcn_rcpf(d.x); r.y = __builtin_amdgcn_rcpf(d.y);
        return (xg * r) * (xl * (f2){H_SCALE, H_SCALE} + (f2){H_SCALE, H_SCALE});
    }
    __device__ __forceinline__ void operator()(const f32x4 (&acc)[2][2][4][2], const pg8::Unit& u, int wr, int wc, int fr, int fq) const {
        const int e = u.pn >> 4, pnl = u.pn & 15, pc = wc * 32 + 8 * fq;
        const float* bp = b1p + e * 4096 + pnl * 256 + pc;
        const f32x4 bg0 = *(const f32x4*)(bp), bg1 = *(const f32x4*)(bp + 4), bl0 = *(const f32x4*)(bp + 128), bl1 = *(const f32x4*)(bp + 132);
        const int row0 = u.pm * 256 + wr * 64 + fr;
        float dqv = 1.0f / (W_SCALE * X_SCALE); asm volatile("" : "+s"(dqv));
        const f2 dq2 = (f2){dqv, dqv};
#pragma unroll
        for (int ai = 0; ai < 2; ++ai)
#pragma unroll
            for (int m = 0; m < 4; ++m) {
                const int row = row0 + ai * 128 + m * 16;
                const f32x4 ag0 = acc[ai][0][m][0], ag1 = acc[ai][0][m][1], al0 = acc[ai][1][m][0], al1 = acc[ai][1][m][1];
                const f2 o0 = act2(ag0.xy, al0.xy, bg0.xy, bl0.xy, dq2), o1 = act2(ag0.zw, al0.zw, bg0.zw, bl0.zw, dq2);
                const f2 o2 = act2(ag1.xy, al1.xy, bg1.xy, bl1.xy, dq2), o3 = act2(ag1.zw, al1.zw, bg1.zw, bl1.zw, dq2);
                int w0 = 0, w1 = 0;
                w0 = __builtin_amdgcn_cvt_pk_fp8_f32(o0.x, o0.y, w0, false); w0 = __builtin_amdgcn_cvt_pk_fp8_f32(o1.x, o1.y, w0, true);
                w1 = __builtin_amdgcn_cvt_pk_fp8_f32(o2.x, o2.y, w1, false); w1 = __builtin_amdgcn_cvt_pk_fp8_f32(o3.x, o3.y, w1, true);
                u32x2 w; w.x = (unsigned)w0; w.y = (unsigned)w1;
                *(u32x2*)(H + (size_t)row * DFF + pnl * 128 + pc) = w;
            }
    }
};
struct EpiY {
    static constexpr bool PERM = true, AFTER_DRAIN = false, FP8 = true;
    bf16_t* Y; const float* b2; const float* gate;
    __device__ __forceinline__ void operator()(const f32x4 (&acc)[2][2][4][2], const pg8::Unit& u, int wr, int wc, int fr, int fq) const {
        const int e = u.pn >> 3, pnl = u.pn & 7, col0 = pnl * 256 + wc * 32 + 8 * fq;
        const float* bp = b2 + e * DM + col0;
        f32x4 bv[2][2];
#pragma unroll
        for (int bj = 0; bj < 2; ++bj)
#pragma unroll
            for (int n = 0; n < 2; ++n) bv[bj][n] = *(const f32x4*)(bp + bj * 128 + 4 * n);
        const int row0 = u.pm * 256 + wr * 64 + fr;
        float dqv = 1.0f / (W_SCALE * H_SCALE); asm volatile("" : "+s"(dqv));
#pragma unroll
        for (int ai = 0; ai < 2; ++ai)
#pragma unroll
            for (int m = 0; m < 4; ++m) {
                const int row = row0 + ai * 128 + m * 16;
                const float gt = gate[row];
#pragma unroll
                for (int bj = 0; bj < 2; ++bj) {
                    const f32x4 v0 = (acc[ai][bj][m][0] * dqv + bv[bj][0]) * (gt * Y_SCALE), v1 = (acc[ai][bj][m][1] * dqv + bv[bj][1]) * (gt * Y_SCALE);
                    u32x2 w; w.x = cvt4_fp8(v0[0], v0[1], v0[2], v0[3]); w.y = cvt4_fp8(v1[0], v1[1], v1[2], v1[3]);
                    *(u32x2*)((unsigned char*)Y + (size_t)row * DM + col0 + bj * 128) = w;
                }
            }
    }
};

struct MoeOrder {
    int nM, nN, nwg, G, c; const LAS int* tile_e;
    __device__ void init(int nM_, int nN_, int G_, int c_, const LAS int* te) { nM = nM_; nN = nN_; nwg = nM * nN; G = G_; c = c_; tile_e = te; }
    __device__ bool next(int i, pg8::Unit& u) const {
        const long L = (long)i * G + c; if (L >= nwg) return false;
        int wgid = (int)L; { const int q = nwg / pg8::NXCD, r = nwg % pg8::NXCD, xcd = wgid % pg8::NXCD, off = wgid / pg8::NXCD; wgid = (xcd < r ? xcd * (q + 1) : r * (q + 1) + (xcd - r) * q) + off; }
        const int nig = pg8::WGM * nN, gid = wgid / nig, fm = gid * pg8::WGM, gsz = (nM - fm) < pg8::WGM ? (nM - fm) : pg8::WGM;
        u.pm = fm + ((wgid % nig) % gsz); const int pnl = (wgid % nig) / gsz; u.pn = __builtin_amdgcn_readfirstlane(tile_e[u.pm]) * nN + pnl; return true;
    }
    __device__ __forceinline__ void a_ready(const pg8::Unit&) const {}
    __device__ __forceinline__ void done(const pg8::Unit&) const {}
    static constexpr bool GATHER = false; const int* rowtok;
};
struct MoeGather : MoeOrder { static constexpr bool GATHER = true; };

__device__ __forceinline__ void build_tiles(const Params& p, LAS int* tb) {
    if (threadIdx.x < NE) tb[128 + 256 + threadIdx.x] = p.gcnt[threadIdx.x];
    __syncthreads();
    if (threadIdx.x == 0) {
        int t = 0;
        for (int e = 0; e < NE; ++e) {
            const int c = tb[128 + 256 + e], nt = (c + 255) >> 8;
            tb[1 + e] = t * 256;
            for (int k = 0; k < nt; ++k) tb[64 + t + k] = e;
            t += nt;
        }
        tb[0] = t;
    }
    __syncthreads();
}

__device__ __forceinline__ void ret_prepass(const Params& p, LAS unsigned char* lds, int bid, int nb) {
    const int tid = threadIdx.x, lane = tid & 63, wid = tid >> 6, quad = lane >> 4, l15 = lane & 15;
    LAS bf16_t* Qs = (LAS bf16_t*)lds;
    LAS bf16_t* Ks = Qs + 64 * 264;
    LAS bf16_t* Ps = Ks + 64 * 264;
    u32x4 rq[4], rk[4];
#define RP_ISSUE(u_) do { const int _h = (u_) & 7, _n = ((u_) >> 3) & 63, _b = (u_) >> 9; \
        _Pragma("unroll") for (int i = 0; i < 4; ++i) { const int piece = tid + NTHREADS * i, row = piece >> 5, cc = (piece & 31) * 8; \
            const bf16_t* rp = p.z + (size_t)(_b * SEQ + _n * 64 + row) * NZ + _h * 256 + cc; rq[i] = *(const u32x4*)(rp); rk[i] = *(const u32x4*)(rp + 2048); } } while (0)
    int u = bid;
    if (u < 2048) RP_ISSUE(u);
    for (; u < 2048; u += nb) {
        const int h = u & 7;
        const float lg2 = log2f(1.0f - exp2f(-5.0f - (float)h));
#pragma unroll
        for (int i = 0; i < 4; ++i) { const int piece = tid + NTHREADS * i, row = piece >> 5, cc = (piece & 31) * 8; *(LAS u32x4*)(Qs + row * 264 + cc) = rq[i]; *(LAS u32x4*)(Ks + row * 264 + cc) = rk[i]; }
        if (u + nb < 2048) RP_ISSUE(u + nb);
        __syncthreads();
        {
            const int mi = wid >> 1, nb0 = (wid & 1) * 2;
            f32x4 a0 = (f32x4){0.f, 0.f, 0.f, 0.f}, a1 = a0;
#pragma unroll
            for (int ks = 0; ks < 8; ++ks) {
                const bf16x8 A = ldfrag(Qs, 264, mi * 16, ks * 32, lane);
                a0 = mma16(A, ldfrag(Ks, 264, nb0 * 16, ks * 32, lane), a0); a1 = mma16(A, ldfrag(Ks, 264, nb0 * 16 + 16, ks * 32, lane), a1);
            }
#pragma unroll
            for (int jj = 0; jj < 4; ++jj) {
                const int i = mi * 16 + quad * 4 + jj, j0 = nb0 * 16 + l15, j1 = j0 + 16;
                Ps[i * 72 + j0] = f2bf(a0[jj] * exp2f(fabsf((float)(i - j0)) * lg2));
                Ps[i * 72 + j1] = f2bf(a1[jj] * exp2f(fabsf((float)(i - j1)) * lg2));
            }
        }
        {
#pragma unroll
            for (int i = 0; i < 4; ++i) {
                const int piece = tid + NTHREADS * i, dk = piece & 255, j0 = (piece >> 8) * 8;
                float v[8];
#pragma unroll
                for (int e = 0; e < 8; ++e) v[e] = bf2f(Ks[(j0 + e) * 264 + dk]) * exp2f((float)(63 - j0 - e) * lg2);
                u32x4 w; w.x = cvt2(v[0], v[1]); w.y = cvt2(v[2], v[3]); w.z = cvt2(v[4], v[5]); w.w = cvt2(v[6], v[7]);
                *(u32x4*)(p.kt + ((size_t)u * 256 + dk) * 64 + j0) = w;
            }
        }
        __syncthreads();
        { const int row = tid >> 3, c8 = (tid & 7) * 8; *(u32x4*)(p.pr + (size_t)u * 4096 + row * 64 + c8) = *(const LAS u32x4*)(Ps + row * 72 + c8); }
    }
#undef RP_ISSUE
}

struct Cv2Tile { const float* src; unsigned char* dst; int c0; };
__device__ __forceinline__ Cv2Tile cv_decode_w2(const Params& p, int s) {
    const int e = s >> 9, r = s & 511, kt = r >> 3, ct = r & 7;
    Cv2Tile t; t.src = p.w2 + (size_t)e * DFF * DM + (size_t)(kt * 32) * DM + ct * 256; t.dst = (unsigned char*)p.w2t + (size_t)e * DM * DFF + kt * 32; t.c0 = ct * 256; return t;
}
#define W2Q_DEC(q_) const int _w = bid + 256 * ((q_) >> 2), _e = _w >> 7, _kt = ((_w >> 3) & 15) * 4 + ((q_) & 3), _ct = _w & 7
#define W2Q_LOAD(cvr, q_) do { W2Q_DEC(q_); const float* _sp = p.w2 + (size_t)_e * DFF * DM + (size_t)(_kt * 32 + (tid >> 6) * 4) * DM + _ct * 256 + (tid & 63) * 4; \
        _Pragma("unroll") for (int i = 0; i < 4; ++i) cvr[i] = *(const f32x4*)(_sp + (size_t)i * DM); } while (0)
#define W2Q_TILE(q_) ((LAS unsigned*)(lds + 48128) + (((q_) >> 2) & 1) * (4 * 2320) + ((q_) & 3) * 2320)
#define W2Q_OUT(q_) do { W2Q_DEC(q_); const int _pc = tid & 7; const LAS unsigned* _tb = (const LAS unsigned*)(lds + 48128) + (((q_) >> 2) & 1) * (4 * 2320) + (_pc >> 1) * 2320 + (_pc & 1) * 4; \
        unsigned char* _db = (unsigned char*)p.w2t + (size_t)_e * DM * DFF + (_kt >> 2) * 128 + _pc * 16; \
        _Pragma("unroll") for (int r = 0; r < 4; ++r) { const int _col = r * 64 + (tid >> 3); const LAS unsigned* _tw = _tb + _col * 9; \
            u32x4 _v; _v.x = _tw[0]; _v.y = _tw[1]; _v.z = _tw[2]; _v.w = _tw[3]; *(u32x4*)(_db + (size_t)(_ct * 256 + _col) * DFF) = _v; } } while (0)
#define W2_LOAD(cvr, s_) do { const Cv2Tile _t = cv_decode_w2(p, (s_)); const float* _sp = _t.src + (size_t)((tid >> 6) * 4) * DM + (tid & 63) * 4; \
        _Pragma("unroll") for (int i = 0; i < 4; ++i) cvr[i] = *(const f32x4*)(_sp + (size_t)i * DM); } while (0)
#define W2_WRITE(cvr, tl_) do { LAS unsigned* _tw = (LAS unsigned*)(tl_); _Pragma("unroll") for (int c = 0; c < 4; ++c) \
        _tw[((tid & 63) * 4 + c) * 9 + (tid >> 6)] = cvt4_fp8(cvr[0][c] * W_SCALE, cvr[1][c] * W_SCALE, cvr[2][c] * W_SCALE, cvr[3][c] * W_SCALE); } while (0)
#define W2_OUT(tl_, s_) do { const Cv2Tile _t = cv_decode_w2(p, (s_)); const int _col = tid & 255, _kq = tid >> 8; const LAS unsigned* _tw = (const LAS unsigned*)(tl_) + _col * 9 + _kq * 4; \
        u32x4 _w; _w.x = _tw[0]; _w.y = _tw[1]; _w.z = _tw[2]; _w.w = _tw[3]; \
        *(u32x4*)(_t.dst + (size_t)(_t.c0 + _col) * DFF + _kq * 16) = _w; } while (0)
__device__ __forceinline__ void hg_prepass(const Params& p, LAS unsigned char* lds, int bid, int nb) {
    const int tid = threadIdx.x, lane = tid & 63, wid = tid >> 6, quad = lane >> 4, l15 = lane & 15, d = tid & 127, g = tid >> 7;
    LAS bf16_t* As = (LAS bf16_t*)lds;
    LAS bf16_t* Bs = As + 64 * 136;
    LAS bf16_t* Ps = Bs + 64 * 136;
    LAS float* cpart = (LAS float*)(Ps + 64 * 72);
    unsigned short rqh[16], rfh[16];
    LAS unsigned char* wt0 = lds + 48128; LAS unsigned char* wt1 = wt0 + 9216;
    const bool host = (nb == 256);
    f32x4 cvA[4], cvB[4];
#define HP_ISSUE(u_) do { const int _h = (u_) & 15, _n = ((u_) >> 4) & 63, _b = (u_) >> 10; const bf16_t* _zq = p.z + (size_t)(_b * SEQ + _n * 64 + 16 * g) * NZ + 8192 + _h * 128 + d; \
        _Pragma("unroll") for (int r = 0; r < 16; ++r) { rqh[r] = _zq[(size_t)r * NZ]; rfh[r] = _zq[(size_t)r * NZ + 2048]; } } while (0)
    int it = 0, u = bid;
    if (u < 4096) HP_ISSUE(u);
    if (host) { W2Q_LOAD(cvA, 0); W2Q_LOAD(cvB, 1); }
    for (; u < 4096; u += nb, ++it) {
        const int h = u & 15, n = (u >> 4) & 63, b = u >> 10;
        const float lbv = 1.0f / (1.0f + __expf(p.lb_logits[DM + h * 128 + d] - p.lb_logits[h * 128 + d]));
        const float om = 1.0f - lbv;
        bf16_t* zq = p.z + (size_t)(b * SEQ + n * 64 + 16 * g) * NZ + 8192 + h * 128 + d;
#if DIAG == 1 || DIAG == 2
        { bf16_t* dq_ = p.dz + (size_t)(b * SEQ + n * 64 + 16 * g) * 4096 + h * 128 + d;
#pragma unroll
          for (int r = 0; r < 16; ++r) { dq_[(size_t)r * 4096] = rqh[r]; dq_[(size_t)r * 4096 + 2048] = rfh[r]; } }
#endif
        float cl[16], kk[16], qv[16]; float c = 0.f;
#pragma unroll
        for (int r = 0; r < 16; ++r) { const float sg = __builtin_amdgcn_rcpf(1.0f + ex2_(bf2f(rfh[r]) * -1.4426950408889634f)); const float f = lbv + om * sg; c += lg2_(f); cl[r] = c; kk[r] = om * (1.0f - sg); qv[r] = bf2f(rqh[r]); }
        if (u + nb < 4096) HP_ISSUE(u + nb);
        LAS float* cp = cpart + (it & 1) * 512;
        cp[g * 128 + d] = c;
        if (host) { W2_WRITE(cvA, W2Q_TILE(2 * it)); if (it + 1 < 16) W2Q_LOAD(cvA, 2 * it + 2); }
        __syncthreads();
        float off = 0.f, tot = 0.f;
#pragma unroll
        for (int gg = 0; gg < 4; ++gg) { const float v = cp[gg * 128 + d]; tot += v; off += (gg < g) ? v : 0.f; }
        const float etot = ex2_(tot);
        unsigned k2p[8];
#pragma unroll
        for (int r = 0; r < 16; r += 2) {
            float k2v[2];
#pragma unroll
            for (int q = 0; q < 2; ++q) {
                const float cum = off + cl[r + q];
                const float ea = ex2_(cum), bb = kk[r + q] * ex2_(-cum);
                k2v[q] = bb * etot;
                const bf16_t av = f2bf(qv[r + q] * ea * __builtin_amdgcn_rcpf(1.0f + ex2_(qv[r + q] * -1.4426950408889634f)));
                zq[(size_t)(r + q) * NZ] = av;
                As[(16 * g + r + q) * 136 + d] = av; Bs[(16 * g + r + q) * 136 + d] = f2bf(bb);
            }
            k2p[r >> 1] = cvt2(k2v[0], k2v[1]);
        }
        bf16_t* kd = p.k2t + ((size_t)u * 128 + d) * 64 + 16 * g;
        *(u32x4*)(kd) = (u32x4){k2p[0], k2p[1], k2p[2], k2p[3]};
        *(u32x4*)(kd + 8) = (u32x4){k2p[4], k2p[5], k2p[6], k2p[7]};
        if (g == 0) p.e63[u * 128 + d] = etot;
        if (host) { W2_WRITE(cvB, W2Q_TILE(2 * it + 1)); if (it + 1 < 16) W2Q_LOAD(cvB, 2 * it + 3); }
        __syncthreads();
        if (host && (it & 1)) W2Q_OUT(2 * it + 1);
        {
            const int mi = wid >> 1, nb0 = (wid & 1) * 2;
            f32x4 a0 = (f32x4){0.f, 0.f, 0.f, 0.f}, a1 = a0;
#pragma unroll
            for (int ks = 0; ks < 4; ++ks) {
                const bf16x8 A = ldfrag(As, 136, mi * 16, ks * 32, lane);
                a0 = mma16(A, ldfrag(Bs, 136, nb0 * 16, ks * 32, lane), a0); a1 = mma16(A, ldfrag(Bs, 136, nb0 * 16 + 16, ks * 32, lane), a1);
            }
#pragma unroll
            for (int jj = 0; jj < 4; ++jj) {
                const int i = mi * 16 + quad * 4 + jj, j0 = nb0 * 16 + l15, j1 = j0 + 16;
                bf16_t* pd = p.ph + (size_t)u * 4096 + i * 64;
                pd[j0] = (i >= j0) ? f2bf(a0[jj]) : (bf16_t)0; pd[j1] = (i >= j1) ? f2bf(a1[jj]) : (bf16_t)0;
            }
        }
    }
#undef HP_ISSUE
}


struct CvTile { const float* src; unsigned char* dst; int c0; };
__device__ __forceinline__ CvTile cv_decode_w1(const Params& p, int s) {
    const int e = s >> 10, r = s & 1023, kt = r >> 4, ct = r & 15;
    CvTile t; t.src = p.w1 + (size_t)e * DM * 4096 + (size_t)(kt * 32) * 4096 + ct * 256; t.dst = (unsigned char*)p.w1t + (size_t)e * 4096 * DM + kt * 32; t.c0 = ct * 256; return t;
}
#define CV_LOAD(s_) do { const CvTile _t = cv_decode_w1(p, (s_)); const float* _sp = _t.src + (size_t)((tid >> 6) * 4) * 4096 + (tid & 63) * 4; \
        _Pragma("unroll") for (int i = 0; i < 4; ++i) cv[i] = *(const f32x4*)(_sp + (size_t)i * 4096); } while (0)
#define CV_WRITE() do { LAS unsigned* _tw = (LAS unsigned*)cvt_; _Pragma("unroll") for (int c = 0; c < 4; ++c) \
        _tw[((tid & 63) * 4 + c) * 9 + (tid >> 6)] = cvt4_fp8(cv[0][c] * W_SCALE, cv[1][c] * W_SCALE, cv[2][c] * W_SCALE, cv[3][c] * W_SCALE); } while (0)
#define CV_OUT(s_) do { const CvTile _t = cv_decode_w1(p, (s_)); const int _col = tid & 255, _kq = tid >> 8, _g = _t.c0 + _col, _j = _g >> 1; \
        const int _drow = (_j >> 7) * 256 + (_g & 1) * 128 + (_j & 127); const LAS unsigned* _tw = (const LAS unsigned*)cvt_ + _col * 9 + _kq * 4; \
        u32x4 _w; _w.x = _tw[0]; _w.y = _tw[1]; _w.z = _tw[2]; _w.w = _tw[3]; \
        *(u32x4*)(_t.dst + (size_t)_drow * DM + _kq * 16) = _w; } while (0)

__device__ __forceinline__ void mixer_ret(const Params& p, LAS unsigned char* lds, int unit, int cvbase) {
    const int tid = threadIdx.x, lane = tid & 63, wid = tid >> 6, quad = lane >> 4, l15 = lane & 15;
    const int sl = unit & 7, h = (unit >> 3) & 7, b = unit >> 6;
    LAS bf16_t* Qs = (LAS bf16_t*)lds;
    LAS bf16_t* KTs = Qs + 64 * 264;
    LAS bf16_t* Ps = KTs + 256 * 72;
    LAS bf16_t* Vt = Ps + 64 * 72;
    LAS bf16_t* St = Vt + 32 * 72;
    LAS float* cvt_ = (LAS float*)(lds + 118272);
    f32x4 cv[4];
    const float lg2 = log2f(1.0f - exp2f(-5.0f - (float)h));
    const float g64 = exp2f(64.0f * lg2);
    for (int i = tid; i < 2 * 32 * 264 / 2; i += NTHREADS) ((LAS unsigned*)St)[i] = 0u;
    f32x4 Sacc[2][2];
#pragma unroll
    for (int a = 0; a < 2; ++a)
#pragma unroll
        for (int c = 0; c < 2; ++c) Sacc[a][c] = (f32x4){0.f, 0.f, 0.f, 0.f};
    const bf16_t* zb = p.z + (size_t)(b * SEQ) * NZ;
    const int qcol = h * 256, vcol = 4096 + h * 256 + sl * 32;
    u32x4 rq[4], rk[4], rp, rv = (u32x4){0u, 0u, 0u, 0u};
#define RET_ISSUE(n) do { const size_t un = (size_t)((b * 64 + (n)) * 8 + h); \
        _Pragma("unroll") for (int i = 0; i < 4; ++i) { const int piece = tid + NTHREADS * i; \
            { const int row = piece >> 5, cc = (piece & 31) * 8; rq[i] = *(const u32x4*)(zb + (size_t)((n) * 64 + row) * NZ + qcol + cc); } \
            { const int dk = piece >> 3, jc = (piece & 7) * 8; rk[i] = *(const u32x4*)(p.kt + (un * 256 + dk) * 64 + jc); } } \
        { const int row = tid >> 3, c8 = (tid & 7) * 8; rp = *(const u32x4*)(p.pr + un * 4096 + row * 64 + c8); } \
        if (tid < 256) { const int row = tid >> 2, cc = (tid & 3) * 8; rv = *(const u32x4*)(zb + (size_t)((n) * 64 + row) * NZ + vcol + cc); } } while (0)
    LAS bf16_t* Ot = (LAS bf16_t*)(lds + 127488);
#define RET_OSTORE(nn) do { if (tid < 256) { const int _row = tid >> 2, _sg = tid & 3; \
        *(u32x4*)(p.o_r + (size_t)(b * SEQ + (nn) * 64 + _row) * DM + h * 256 + sl * 32 + _sg * 8) = *(const LAS u32x4*)(Ot + _row * 40 + _sg * 8); } } while (0)
    float xi4[4];
#pragma unroll
    for (int jj = 0; jj < 4; ++jj) xi4[jj] = exp2f((float)((wid >> 1) * 16 + quad * 4 + jj + 1) * lg2);
    RET_ISSUE(0);
    if (cvbase >= 0) CV_LOAD(cvbase);
    int cur = 0;
    for (int n = 0; n < 64; ++n) {
#pragma unroll
        for (int i = 0; i < 4; ++i) {
            const int piece = tid + NTHREADS * i;
            { const int row = piece >> 5, cc = (piece & 31) * 8; *(LAS u32x4*)(Qs + row * 264 + cc) = rq[i]; }
            { const int dk = piece >> 3, jc = (piece & 7) * 8; *(LAS u32x4*)(KTs + dk * 72 + jc) = rk[i]; }
        }
        { const int row = tid >> 3, c8 = (tid & 7) * 8; *(LAS u32x4*)(Ps + row * 72 + c8) = rp; }
        if (tid < 256) {
            const int row = tid >> 2, cc = (tid & 3) * 8;
#pragma unroll
            for (int j = 0; j < 4; ++j) { const unsigned wv = rv[j]; Vt[(cc + 2 * j) * 72 + row] = (bf16_t)(wv & 0xffffu); Vt[(cc + 2 * j + 1) * 72 + row] = (bf16_t)(wv >> 16); }
        }
        if (cvbase >= 0) { CV_WRITE(); if (n + 1 < 64) CV_LOAD(cvbase + 256 * (n + 1)); }
        if (n + 1 < 64) RET_ISSUE(n + 1);
        if (n > 0) RET_OSTORE(n - 1);
        __syncthreads();
        const LAS bf16_t* So = St + cur * (32 * 264); LAS bf16_t* Sn = St + (cur ^ 1) * (32 * 264);
        {
            const int mi = wid >> 1, ni = wid & 1;
            f32x4 a1 = (f32x4){0.f, 0.f, 0.f, 0.f}, a2 = a1;
#pragma unroll
            for (int ks = 0; ks < 2; ++ks) a1 = mma16(ldfrag(Ps, 72, mi * 16, ks * 32, lane), ldfrag(Vt, 72, ni * 16, ks * 32, lane), a1);
#pragma unroll
            for (int ks = 0; ks < 8; ++ks) a2 = mma16(ldfrag(Qs, 264, mi * 16, ks * 32, lane), ldfrag(So, 264, ni * 16, ks * 32, lane), a2);
#pragma unroll
            for (int jj = 0; jj < 4; ++jj) {
                const int i = mi * 16 + quad * 4 + jj;
                Ot[i * 40 + ni * 16 + l15] = f2bf(a1[jj] + xi4[jj] * a2[jj]);
            }
        }
        {
#pragma unroll
            for (int mt = 0; mt < 2; ++mt) {
                const int mi = wid * 2 + mt;
#pragma unroll
                for (int ni = 0; ni < 2; ++ni) {
                    f32x4 s = Sacc[mt][ni] * g64;
#pragma unroll
                    for (int ks = 0; ks < 2; ++ks) s = mma16(ldfrag(KTs, 72, mi * 16, ks * 32, lane), ldfrag(Vt, 72, ni * 16, ks * 32, lane), s);
                    Sacc[mt][ni] = s;
                    u32x2 w; w.x = cvt2(s[0], s[1]); w.y = cvt2(s[2], s[3]);
                    *(LAS u32x2*)(Sn + (ni * 16 + l15) * 264 + mi * 16 + quad * 4) = w;
                }
            }
        }
        if (cvbase >= 0) CV_OUT(cvbase + 256 * n);
        __syncthreads();
        cur ^= 1;
    }
    RET_OSTORE(63);
    __syncthreads();
#undef RET_ISSUE
#undef RET_OSTORE
}

#define HCV_DEC(n_) const int _w = bid_ + 256 * ((n_) >> 2), _e = 16 + (_w >> 8), _kt = ((_w >> 4) & 15) * 4 + ((n_) & 3), _ct = _w & 15
#define HCV_LOAD(n_) do { HCV_DEC(n_); const float* _sp = p.w1 + (size_t)_e * DM * 4096 + (size_t)(_kt * 32 + (tid >> 6) * 4) * 4096 + _ct * 256 + (tid & 63) * 4; \
        _Pragma("unroll") for (int i = 0; i < 4; ++i) cv[i] = *(const f32x4*)(_sp + (size_t)i * 4096); } while (0)
#define HCV_WRITE(n_) do { LAS unsigned* _tw = (LAS unsigned*)cvt_ + ((n_) & 3) * 2320; _Pragma("unroll") for (int c = 0; c < 4; ++c) \
        _tw[((tid & 63) * 4 + c) * 9 + (tid >> 6)] = cvt4_fp8(cv[0][c] * W_SCALE, cv[1][c] * W_SCALE, cv[2][c] * W_SCALE, cv[3][c] * W_SCALE); } while (0)
#define HCV_OUT(n_) do { HCV_DEC(n_); const int _pc = tid & 7; const LAS unsigned* _tb = (const LAS unsigned*)cvt_ + (_pc >> 1) * 2320 + (_pc & 1) * 4; \
        unsigned char* _db = (unsigned char*)p.w1t + (size_t)_e * 4096 * DM + (_kt >> 2) * 128 + _pc * 16; \
        _Pragma("unroll") for (int r = 0; r < 4; ++r) { const int _col = r * 64 + (tid >> 3), _g = _ct * 256 + _col, _j = _g >> 1, _drow = (_j >> 7) * 256 + (_g & 1) * 128 + (_j & 127); \
            const LAS unsigned* _tw = _tb + _col * 9; u32x4 _v; _v.x = _tw[0]; _v.y = _tw[1]; _v.z = _tw[2]; _v.w = _tw[3]; *(u32x4*)(_db + (size_t)_drow * DM) = _v; } } while (0)
__device__ __forceinline__ void mixer_hg(const Params& p, LAS unsigned char* lds, int unit, int cvbase) {
    const int tid = threadIdx.x, lane = tid & 63, wid = tid >> 6, quad = lane >> 4, l15 = lane & 15;
    const int sl = unit & 3, h = (unit >> 2) & 15, b = unit >> 6;
    LAS bf16_t* As = (LAS bf16_t*)lds;
    LAS bf16_t* K2t = As + 64 * 136;
    LAS bf16_t* Ps = K2t + 128 * 72;
    LAS bf16_t* Vt = Ps + 64 * 72;
    LAS bf16_t* St = Vt + 32 * 72;
    LAS float* e63 = (LAS float*)(St + 2 * 32 * 136);
    LAS float* cvt_ = (LAS float*)(lds + 67584);
    const int bid_ = cvbase & 255;
    f32x4 cv[4];
    for (int i = tid; i < 2 * 32 * 136 / 2; i += NTHREADS) ((LAS unsigned*)St)[i] = 0u;
    LAS bf16_t* Ot = (LAS bf16_t*)(lds + 104704);
#define HG_OSTORE(nn) do { if (tid < 256) { const int _row = tid >> 2, _sg = tid & 3; \
        *(u32x4*)(p.o_h + (size_t)(b * SEQ + (nn) * 64 + _row) * DM + h * 128 + sl * 32 + _sg * 8) = *(const LAS u32x4*)(Ot + _row * 40 + _sg * 8); } } while (0)
    f32x4 Sacc[2];
    Sacc[0] = (f32x4){0.f, 0.f, 0.f, 0.f}; Sacc[1] = Sacc[0];
    const bf16_t* zb = p.z + (size_t)(b * SEQ) * NZ;
    const int acol = 8192 + h * 128, vcol = 12288 + h * 128 + sl * 32;
    u32x4 ra[2], rk[2], rp, rv = (u32x4){0u, 0u, 0u, 0u}; float re = 0.f;
#define HG_ISSUE(n) do { const size_t un = (size_t)((b * 64 + (n)) * 16 + h); \
        _Pragma("unroll") for (int i = 0; i < 2; ++i) { const int piece = tid + NTHREADS * i; \
            { const int row = piece >> 4, cc = (piece & 15) * 8; ra[i] = *(const u32x4*)(zb + (size_t)((n) * 64 + row) * NZ + acol + cc); } \
            { const int dd = piece >> 3, mc = (piece & 7) * 8; rk[i] = *(const u32x4*)(p.k2t + (un * 128 + dd) * 64 + mc); } } \
        { const int row = tid >> 3, c8 = (tid & 7) * 8; rp = *(const u32x4*)(p.ph + un * 4096 + row * 64 + c8); } \
        if (tid < 256) { const int row = tid >> 2, cc = (tid & 3) * 8; rv = *(const u32x4*)(zb + (size_t)((n) * 64 + row) * NZ + vcol + cc); } \
        if (tid < 128) re = p.e63[un * 128 + tid]; } while (0)
    HG_ISSUE(0);
    if (cvbase >= 0) HCV_LOAD(0);
    int cur = 0;
    for (int n = 0; n < 64; ++n) {
#pragma unroll
        for (int i = 0; i < 2; ++i) {
            const int piece = tid + NTHREADS * i;
            { const int row = piece >> 4, cc = (piece & 15) * 8; *(LAS u32x4*)(As + row * 136 + cc) = ra[i]; }
            { const int dd = piece >> 3, mc = (piece & 7) * 8; *(LAS u32x4*)(K2t + dd * 72 + mc) = rk[i]; }
        }
        { const int row = tid >> 3, c8 = (tid & 7) * 8; *(LAS u32x4*)(Ps + row * 72 + c8) = rp; }
        if (tid < 256) {
            const int row = tid >> 2, cc = (tid & 3) * 8;
#pragma unroll
            for (int j = 0; j < 4; ++j) { const unsigned wv = rv[j]; Vt[(cc + 2 * j) * 72 + row] = (bf16_t)(wv & 0xffffu); Vt[(cc + 2 * j + 1) * 72 + row] = (bf16_t)(wv >> 16); }
        }
        if (tid < 128) e63[tid] = re;
        if (cvbase >= 0) { HCV_WRITE(n); if (n + 1 < 64) HCV_LOAD(n + 1); }
        if (n + 1 < 64) HG_ISSUE(n + 1);
        if (n > 0) HG_OSTORE(n - 1);
        __syncthreads();
        const LAS bf16_t* So = St + cur * (32 * 136); LAS bf16_t* Sn = St + (cur ^ 1) * (32 * 136);
        {
            const int mi = wid >> 1, ni = wid & 1;
            f32x4 a = (f32x4){0.f, 0.f, 0.f, 0.f};
#pragma unroll
            for (int ks = 0; ks < 2; ++ks) a = mma16(ldfrag(Ps, 72, mi * 16, ks * 32, lane), ldfrag(Vt, 72, ni * 16, ks * 32, lane), a);
#pragma unroll
            for (int ks = 0; ks < 4; ++ks) a = mma16(ldfrag(As, 136, mi * 16, ks * 32, lane), ldfrag(So, 136, ni * 16, ks * 32, lane), a);
#pragma unroll
            for (int jj = 0; jj < 4; ++jj) {
                const int i = mi * 16 + quad * 4 + jj;
                Ot[i * 40 + ni * 16 + l15] = f2bf(a[jj]);
            }
        }
        {
            const int mi = wid;
            const f32x4 ev = *(const LAS f32x4*)(e63 + mi * 16 + quad * 4);
#pragma unroll
            for (int ni = 0; ni < 2; ++ni) {
                f32x4 s = Sacc[ni] * ev;
#pragma unroll
                for (int ks = 0; ks < 2; ++ks) s = mma16(ldfrag(K2t, 72, mi * 16, ks * 32, lane), ldfrag(Vt, 72, ni * 16, ks * 32, lane), s);
                Sacc[ni] = s;
                u32x2 w; w.x = cvt2(s[0], s[1]); w.y = cvt2(s[2], s[3]);
                *(LAS u32x2*)(Sn + (ni * 16 + l15) * 136 + mi * 16 + quad * 4) = w;
            }
        }
        if (cvbase >= 0 && (n & 3) == 3) HCV_OUT(n);
        __syncthreads();
        cur ^= 1;
    }
    HG_OSTORE(63);
    __syncthreads();
#undef HG_ISSUE
#undef HG_OSTORE
#undef HCV_DEC
#undef HCV_LOAD
#undef HCV_WRITE
#undef HCV_OUT
}

__device__ __forceinline__ void unpack8(const u32x4 w, float (&v)[8]) {
#pragma unroll
    for (int j = 0; j < 4; ++j) { v[2 * j] = __uint_as_float(w[j] << 16); v[2 * j + 1] = __uint_as_float(w[j] & 0xffff0000u); }
}
__device__ __forceinline__ void p3_merge(const Params& p, int bid, int nb) {
    const int t = threadIdx.x, c = 8 * (t & 255), rsel = t >> 8;
    float wr8[8], wh8[8];
    { const f32x4 a = *(const f32x4*)(p.ret_nw + c), b = *(const f32x4*)(p.ret_nw + c + 4), e = *(const f32x4*)(p.hg_nw + c), f = *(const f32x4*)(p.hg_nw + c + 4);
#pragma unroll
      for (int j = 0; j < 4; ++j) { wr8[j] = a[j]; wr8[4 + j] = b[j]; wh8[j] = e[j]; wh8[4 + j] = f[j]; } }
    constexpr int R = 2;
    for (int row0 = bid * 2 * R + rsel; row0 < NT; row0 += nb * 2 * R) {
        u32x4 orw[R], ohw[R], gr[R], gh[R];
#pragma unroll
        for (int q = 0; q < R; ++q) {
            const int row = row0 + 2 * q;
            orw[q] = *(const u32x4*)(p.o_r + (size_t)row * DM + c); ohw[q] = *(const u32x4*)(p.o_h + (size_t)row * DM + c);
            gr[q] = *(const u32x4*)(p.gz + (size_t)row * 4096 + c); gh[q] = *(const u32x4*)(p.gz + (size_t)row * 4096 + 2048 + c);
        }
#pragma unroll
        for (int q = 0; q < R; ++q) {
            const int row = row0 + 2 * q;
            float orv[8], ohv[8], grv[8], ghv[8];
            unpack8(orw[q], orv); unpack8(ohw[q], ohv); unpack8(gr[q], grv); unpack8(gh[q], ghv);
            float s = 0.f;
#pragma unroll
            for (int j = 0; j < 8; ++j) s += orv[j];
#pragma unroll
            for (int o = 16; o >= 1; o >>= 1) s += __shfl_xor(s, o);
            const float mean = s * (1.0f / 256.0f);
            float qq = 0.f;
#pragma unroll
            for (int j = 0; j < 8; ++j) { orv[j] -= mean; qq += orv[j] * orv[j]; }
#pragma unroll
            for (int o = 16; o >= 1; o >>= 1) qq += __shfl_xor(qq, o);
            const float rs = rsqrtf(qq * (1.0f / 256.0f) + 1e-6f);
            float q2 = 0.f;
#pragma unroll
            for (int j = 0; j < 8; ++j) q2 += ohv[j] * ohv[j];
#pragma unroll
            for (int o = 8; o >= 1; o >>= 1) q2 += __shfl_xor(q2, o);
            const float rs2 = rsqrtf(q2 * (1.0f / 128.0f) + 1e-6f);
            float o8[8];
#pragma unroll
            for (int j = 0; j < 8; ++j) {
                o8[j] = grv[j] * (orv[j] * rs * wr8[j]) + ghv[j] * (ohv[j] * rs2 * wh8[j]);
            }
            u32x4 w; w.x = cvt2(o8[0], o8[1]); w.y = cvt2(o8[2], o8[3]); w.z = cvt2(o8[4], o8[5]); w.w = cvt2(o8[6], o8[7]);
            *(u32x4*)(p.merged + (size_t)row * DM + c) = w;
        }
    }
}

__device__ __forceinline__ void p5_router(const Params& p, LAS unsigned char* lds, int bid, int nb) {
    const int tid = threadIdx.x, lane = tid & 63, wid = tid >> 6, quad = lane >> 4, l15 = lane & 15;
    constexpr int LD = 2052;
    LAS float* hs = (LAS float*)lds;
    LAS float* red = hs;
    LAS int* le = (LAS int*)(hs + 16 * LD);
    LAS int* lr = le + 256;
    LAS float* lgt = (LAS float*)(lr + 256);
    for (int t0 = bid * 64; t0 < NT; t0 += nb * 64) {
        for (int tile = 0; tile < 4; ++tile) {
#pragma unroll
            for (int tt = 0; tt < 2; ++tt) {
                const int tokl = 2 * wid + tt, tok = t0 + tile * 16 + tokl;
                const u32x4* xr = (const u32x4*)(p.h2b + (size_t)tok * DM);
                float v[4][8]; float ss = 0.f;
#pragma unroll
                for (int i = 0; i < 4; ++i) { unpack8(xr[i * 64 + lane], v[i]);
#pragma unroll
                    for (int j = 0; j < 8; ++j) ss += v[i][j] * v[i][j]; }
                ss = wave_sum(ss);
                const float rstd = rsqrtf(ss * (1.0f / DM) + 1e-6f);
#pragma unroll
                for (int i = 0; i < 4; ++i) {
                    const int c0 = (i * 64 + lane) * 8;
                    const f32x4 w0 = *(const f32x4*)(p.nmoe_w + c0), w1 = *(const f32x4*)(p.nmoe_w + c0 + 4);
                    const f32x4 o0 = (f32x4){v[i][0], v[i][1], v[i][2], v[i][3]} * rstd * w0, o1 = (f32x4){v[i][4], v[i][5], v[i][6], v[i][7]} * rstd * w1;
                    *(LAS f32x4*)(hs + tokl * LD + c0) = o0; *(LAS f32x4*)(hs + tokl * LD + c0 + 4) = o1;
                    u32x2 q; q.x = cvt4_fp8(o0[0] * X_SCALE, o0[1] * X_SCALE, o0[2] * X_SCALE, o0[3] * X_SCALE); q.y = cvt4_fp8(o1[0] * X_SCALE, o1[1] * X_SCALE, o1[2] * X_SCALE, o1[3] * X_SCALE);
                    *(u32x2*)((unsigned char*)p.hn2 + (size_t)tok * DM + c0) = q;
                }
            }
            __syncthreads();
            f32x4 acc[2];
            acc[0] = (f32x4){0.f, 0.f, 0.f, 0.f}; acc[1] = acc[0];
#pragma unroll
            for (int ks = 0; ks < 8; ++ks) {
                const int kb = wid * 256 + ks * 32 + quad * 8;
                const f32x4 x0 = *(const LAS f32x4*)(hs + l15 * LD + kb), x1 = *(const LAS f32x4*)(hs + l15 * LD + kb + 4);
                u32x4 hi; hi.x = cvt2(x0[0], x0[1]); hi.y = cvt2(x0[2], x0[3]); hi.z = cvt2(x1[0], x1[1]); hi.w = cvt2(x1[2], x1[3]);
                u32x4 lo;
                lo.x = cvt2(x0[0] - __uint_as_float(hi.x << 16), x0[1] - __uint_as_float(hi.x & 0xffff0000u));
                lo.y = cvt2(x0[2] - __uint_as_float(hi.y << 16), x0[3] - __uint_as_float(hi.y & 0xffff0000u));
                lo.z = cvt2(x1[0] - __uint_as_float(hi.z << 16), x1[1] - __uint_as_float(hi.z & 0xffff0000u));
                lo.w = cvt2(x1[2] - __uint_as_float(hi.w << 16), x1[3] - __uint_as_float(hi.w & 0xffff0000u));
                const bf16x8 Ahi = __builtin_bit_cast(bf16x8, hi), Alo = __builtin_bit_cast(bf16x8, lo);
#pragma unroll
                for (int nt = 0; nt < 2; ++nt) {
                    const bf16x8 Bhi = *(const bf16x8*)(p.wr_hi + (size_t)(nt * 16 + l15) * DM + kb), Blo = *(const bf16x8*)(p.wr_lo + (size_t)(nt * 16 + l15) * DM + kb);
                    acc[nt] = mma16(Ahi, Bhi, acc[nt]); acc[nt] = mma16(Alo, Bhi, acc[nt]); acc[nt] = mma16(Ahi, Blo, acc[nt]);
                }
            }
            __syncthreads();
#pragma unroll
            for (int nt = 0; nt < 2; ++nt)
#pragma unroll
                for (int jj = 0; jj < 4; ++jj) red[(wid * 16 + quad * 4 + jj) * 32 + nt * 16 + l15] = acc[nt][jj];
            __syncthreads();
#pragma unroll
            for (int tt = 0; tt < 2; ++tt) {
                const int tokl = 2 * wid + tt, tl64 = tile * 16 + tokl;
                float v = -3.0e38f;
                if (lane < 32) { float sv = p.b_router[lane];
#pragma unroll
                    for (int w8 = 0; w8 < 8; ++w8) sv += red[(w8 * 16 + tokl) * 32 + lane];
                    v = sv; }
                float tv[4]; int te[4];
#pragma unroll
                for (int k = 0; k < 4; ++k) {
                    float bv = v; int bi = lane;
#pragma unroll
                    for (int o = 32; o >= 1; o >>= 1) { const float ov = __shfl_xor(bv, o); const int oi = __shfl_xor(bi, o); if (ov > bv || (ov == bv && oi < bi)) { bv = ov; bi = oi; } }
                    tv[k] = bv; te[k] = bi; if (lane == bi) v = -3.0e38f;
                }
                const float e0 = 1.0f, e1 = __expf(tv[1] - tv[0]), e2 = __expf(tv[2] - tv[0]), e3 = __expf(tv[3] - tv[0]);
                const float inv = 1.0f / (e0 + e1 + e2 + e3);
                if (lane < 4) {
                    const int ee = lane == 0 ? te[0] : lane == 1 ? te[1] : lane == 2 ? te[2] : te[3];
                    const float gg = (lane == 0 ? e0 : lane == 1 ? e1 : lane == 2 ? e2 : e3) * inv;
                    le[tl64 * 4 + lane] = ee; lgt[tl64 * 4 + lane] = gg;
                }
            }
            __syncthreads();
        }
        if (tid < 32) {
            int c = 0;
            for (int i = 0; i < 256; ++i) if (le[i] == tid) { lr[i] = c; ++c; }
            p.whist[(t0 >> 6) * 32 + tid] = c;
        }
        __syncthreads();
        if (tid < 256) { const int idx = t0 * 4 + tid; p.tk_e[idx] = le[tid]; p.tk_rank[idx] = lr[tid]; p.tk_g[idx] = lgt[tid]; }
        __syncthreads();
    }
}

__device__ __forceinline__ void p6_gather(const Params& p, LAS unsigned char* lds, LAS int* tb, int bid, int nb) {
    const int tid = threadIdx.x, lane = tid & 63, wid = tid >> 6;
    LAS int* pre = (LAS int*)lds;
    LAS int* raw = pre + 256 * 32;
    LAS int* ctot = raw + 256 * 32;
    for (int i = tid; i < 256 * 32; i += NTHREADS) raw[i] = p.whist[i];
    __syncthreads();
    {
        const int e = tid & 31, ch = tid >> 5;
        int sm = 0;
#pragma unroll
        for (int k = 0; k < 16; ++k) sm += raw[(ch * 16 + k) * 32 + e];
        ctot[ch * 32 + e] = sm;
    }
    __syncthreads();
    {
        const int e = tid & 31, ch = tid >> 5;
        int run = 0, tot = 0;
#pragma unroll
        for (int k = 0; k < 16; ++k) { const int v = ctot[k * 32 + e]; tot += v; run += (k < ch) ? v : 0; }
#pragma unroll
        for (int k = 0; k < 16; ++k) { pre[(ch * 16 + k) * 32 + e] = run; run += raw[(ch * 16 + k) * 32 + e]; }
        if (ch == 0) tb[128 + 256 + e] = tot;
    }
    __syncthreads();
    if (tid == 0) {
        int t = 0;
        for (int e = 0; e < NE; ++e) {
            const int c = tb[128 + 256 + e], nt = (c + 255) >> 8;
            tb[1 + e] = t * 256;
            for (int k = 0; k < nt; ++k) tb[64 + t + k] = e;
            t += nt;
            if (bid == 0) p.gcnt[e] = c;
        }
        tb[0] = t;
    }
    __syncthreads();
    int* rt = (int*)p.xg;
    for (int ent = bid * NTHREADS + tid; ent < NT * 4; ent += nb * NTHREADS) {
        const int e = p.tk_e[ent], tok = ent >> 2, dest = tb[1 + e] + pre[(tok >> 6) * 32 + e] + p.tk_rank[ent];
        rt[dest] = tok; p.row_gate[dest] = p.tk_g[ent]; p.pos[ent] = dest;
    }
    for (int e = 0; e < NE; ++e) {
        const int c = tb[128 + 256 + e], r0 = tb[1 + e] + c, r1 = tb[1 + e] + (((c + 255) >> 8) << 8);
        for (int r = r0 + bid * NTHREADS + tid; r < r1; r += nb * NTHREADS) { rt[r] = 0; p.row_gate[r] = 0.f; }
    }
}

__device__ __forceinline__ void p9_final(const Params& p, int bid, int nb) {
    const int lane = threadIdx.x & 63, wid = __builtin_amdgcn_readfirstlane(threadIdx.x >> 6);
    typedef float f2_ __attribute__((ext_vector_type(2)));
    constexpr float ys = 1.0f / Y_SCALE;
    f32x4 wv[4][2];
#pragma unroll
    for (int i = 0; i < 4; ++i) { const int c = (i * 64 + lane) * 8; wv[i][0] = *(const f32x4*)(p.nfin_w + c); wv[i][1] = *(const f32x4*)(p.nfin_w + c + 4); }
    u32x4 hA[4], hB[4]; u32x2 yA[4][4], yB[4][4];
#define P9_LOAD(H, Y, tk_) do { const int _t = (tk_) < NT ? (tk_) : NT - 1; const u32x4* _hr = (const u32x4*)(p.h2b + (size_t)_t * DM); \
        const int* _pp = p.pos + _t * 4; const int _p0 = _pp[0], _p1 = _pp[1], _p2 = _pp[2], _p3 = _pp[3]; \
        const unsigned char* _y0 = (const unsigned char*)p.y + (size_t)_p0 * DM; const unsigned char* _y1 = (const unsigned char*)p.y + (size_t)_p1 * DM; \
        const unsigned char* _y2 = (const unsigned char*)p.y + (size_t)_p2 * DM; const unsigned char* _y3 = (const unsigned char*)p.y + (size_t)_p3 * DM; \
        _Pragma("unroll") for (int i = 0; i < 4; ++i) { const int c = (i * 64 + lane) * 8; H[i] = _hr[i * 64 + lane]; \
            Y[0][i] = *(const u32x2*)(_y0 + c); Y[1][i] = *(const u32x2*)(_y1 + c); Y[2][i] = *(const u32x2*)(_y2 + c); Y[3][i] = *(const u32x2*)(_y3 + c); } } while (0)
#define P9_STEP(H, Y, tk_) do { float v[4][8]; float ss = 0.f; \
        _Pragma("unroll") for (int i = 0; i < 4; ++i) { unpack8(H[i], v[i]); \
            _Pragma("unroll") for (int hw = 0; hw < 2; ++hw) { \
                const int a0 = (int)(hw ? Y[0][i].y : Y[0][i].x), a1 = (int)(hw ? Y[1][i].y : Y[1][i].x), a2 = (int)(hw ? Y[2][i].y : Y[2][i].x), a3 = (int)(hw ? Y[3][i].y : Y[3][i].x); \
                const f2_ l0 = __builtin_amdgcn_cvt_pk_f32_fp8(a0, false), h0 = __builtin_amdgcn_cvt_pk_f32_fp8(a0, true), l1 = __builtin_amdgcn_cvt_pk_f32_fp8(a1, false), h1 = __builtin_amdgcn_cvt_pk_f32_fp8(a1, true); \
                const f2_ l2 = __builtin_amdgcn_cvt_pk_f32_fp8(a2, false), h2 = __builtin_amdgcn_cvt_pk_f32_fp8(a2, true), l3 = __builtin_amdgcn_cvt_pk_f32_fp8(a3, false), h3 = __builtin_amdgcn_cvt_pk_f32_fp8(a3, true); \
                v[i][4 * hw + 0] += ((l0[0] + l1[0]) + (l2[0] + l3[0])) * ys; v[i][4 * hw + 1] += ((l0[1] + l1[1]) + (l2[1] + l3[1])) * ys; \
                v[i][4 * hw + 2] += ((h0[0] + h1[0]) + (h2[0] + h3[0])) * ys; v[i][4 * hw + 3] += ((h0[1] + h1[1]) + (h2[1] + h3[1])) * ys; } \
            _Pragma("unroll") for (int j = 0; j < 8; ++j) ss += v[i][j] * v[i][j]; } \
        ss = wave_sum(ss); const float rstd = rsqrtf(ss * (1.0f / DM) + 1e-6f); \
        _Pragma("unroll") for (int i = 0; i < 4; ++i) { const int c = (i * 64 + lane) * 8; \
            *(f32x4*)(p.out + (size_t)(tk_) * DM + c) = (f32x4){v[i][0], v[i][1], v[i][2], v[i][3]} * rstd * wv[i][0]; \
            *(f32x4*)(p.out + (size_t)(tk_) * DM + c + 4) = (f32x4){v[i][4], v[i][5], v[i][6], v[i][7]} * rstd * wv[i][1]; } } while (0)
    const int st = nb * 8;
    int tok = bid * 8 + wid;
    P9_LOAD(hA, yA, tok);
    for (; tok < NT; tok += 2 * st) {
        P9_LOAD(hB, yB, tok + st);
        __builtin_amdgcn_sched_barrier(0);
        P9_STEP(hA, yA, tok);
        P9_LOAD(hA, yA, tok + 2 * st);
        __builtin_amdgcn_sched_barrier(0);
        if (tok + st < NT) P9_STEP(hB, yB, tok + st);
    }
#undef P9_LOAD
#undef P9_STEP
}

#if DIAG
__device__ __forceinline__ unsigned hsh(unsigned a, unsigned b) { unsigned x = a * 0x9E3779B1u + b * 0x85EBCA77u + 0x165667B1u; x ^= x >> 15; x *= 0x2C1B3C6Du; x ^= x >> 12; x *= 0x297A2D39u; x ^= x >> 15; return x; }
__device__ __forceinline__ void dacc(float* diag, int stage, float f, float sv, int lane) { if (lane == 0) { atomicAdd(&diag[2 * stage], (f - sv) * (f - sv)); atomicAdd(&diag[2 * stage + 1], sv * sv); } }
__device__ __forceinline__ float swiglu_ref(float g, float l) { const float xg = fminf(g, 7.0f), xl = fminf(fmaxf(l, -7.0f), 7.0f); return xg * (1.0f / (1.0f + expf(-1.702f * xg))) * (xl + 1.0f); }

__device__ void diag_checks(const Params& p, int bid, int nb) {
    const int lane = threadIdx.x & 63, wid = threadIdx.x >> 6;
    float* diag = p.diag;
    for (int rep = 0; rep < 2; ++rep) {
        const unsigned sid = (unsigned)((bid * 8 + wid) * 2 + rep);
        {
            const int row = hsh(sid, 1) % NT, col = hsh(sid, 2) % DM;
            float ss = 0.f; for (int k = lane; k < DM; k += 64) { const float v = p.x[(size_t)row * DM + k]; ss += v * v; }
            ss = wave_sum(ss);
            const float sv = p.x[(size_t)row * DM + col] * rsqrtf(ss / DM + 1e-6f) * p.nmix_w[col];
            dacc(diag, 0, bf2f(p.hn[(size_t)row * DM + col]), sv, lane);
        }
        {
            const int row = hsh(sid, 3) % NT, col = hsh(sid, 4) % NZ;
            float a = 0.f; for (int k = lane; k < DM; k += 64) a += bf2f(p.hn[(size_t)row * DM + k]) * p.w_in[(size_t)k * NZ + col];
            float v = wave_sum(a);
            if (col < 4096) {
                const int hc = col & 255, pr = hc & 127, partner = (col & ~255) + ((hc + 128) & 255);
                float b = 0.f; for (int k = lane; k < DM; k += 64) b += bf2f(p.hn[(size_t)row * DM + k]) * p.w_in[(size_t)k * NZ + partner];
                const float u = wave_sum(b);
                const int sq = row & (SEQ - 1);
                const double ang = (double)sq * (double)powf(10000.0f, -(float)pr / 127.0f);
                const float cs = (float)cos(ang), sn = (float)sin(ang);
                v = (hc < 128) ? (v * cs - u * sn) : (v * cs + u * sn);
                if (col >= 2048) v *= 0.0625f;
            }
            dacc(diag, 1, bf2f(p.z[(size_t)row * NZ + col]), v, lane);
        }
        {
            int b = hsh(sid, 5) & 3, sq = hsh(sid, 6) % SEQ, h = hsh(sid, 7) & 7, c = hsh(sid, 8) & 255;
            if (DIAG_SUB == 1) sq &= 63;
            if (DIAG_SUB == 2) h = 0;
            if (DIAG_SUB == 3) h = 7;
            if (DIAG_SUB == 4) sq = 64 + (sq & 63);
            const int n = sq >> 6;
            const float lg2 = log2f(1.0f - exp2f(-5.0f - (float)h));
            const bf16_t* zb = p.z + (size_t)(b * SEQ) * NZ;
            float q[4];
            for (int t = 0; t < 4; ++t) q[t] = bf2f(zb[(size_t)sq * NZ + h * 256 + lane * 4 + t]);
            float acc = 0.f;
            for (int m = 0; m < 64 * (n + 1); ++m) {
                float d = 0.f;
                for (int t = 0; t < 4; ++t) d += q[t] * bf2f(zb[(size_t)m * NZ + 2048 + h * 256 + lane * 4 + t]);
                d = wave_sum(d);
                const float w = exp2f(fabsf((float)(sq - m)) * lg2);
                acc += w * d * bf2f(zb[(size_t)m * NZ + 4096 + h * 256 + c]);
            }
            dacc(diag, 2, bf2f(p.o_r[(size_t)(b * SEQ + sq) * DM + h * 256 + c]), acc, lane);
        }
        {
            const int b = hsh(sid, 9) & 3, sq = hsh(sid, 10) % SEQ, h = hsh(sid, 11) & 15, c = hsh(sid, 12) & 127;
            const bf16_t* zb = p.z + (size_t)(b * SEQ) * NZ;
            float lbv[2], qs[2], run[2];
            for (int t = 0; t < 2; ++t) {
                const int d = h * 128 + lane * 2 + t;
                lbv[t] = 1.0f / (1.0f + expf(p.lb_logits[DM + d] - p.lb_logits[d]));
                const float qv = bf2f(p.dz[(size_t)(b * SEQ + sq) * 4096 + d]); qs[t] = qv / (1.0f + expf(-qv)); run[t] = 0.f;
            }
            float acc = 0.f;
            const int mlo = sq > 300 ? sq - 300 : 0;
            for (int m = sq; m >= mlo; --m) {
                float term = 0.f, lf[2];
                for (int t = 0; t < 2; ++t) {
                    const float zf = bf2f(p.dz[(size_t)(b * SEQ + m) * 4096 + 2048 + h * 128 + lane * 2 + t]);
                    const float sg = 1.0f / (1.0f + expf(-zf)), f = lbv[t] + (1.0f - lbv[t]) * sg;
                    term += qs[t] * (1.0f - f) * expf(run[t]); lf[t] = logf(f);
                }
                term = wave_sum(term);
                acc += term * bf2f(zb[(size_t)m * NZ + 12288 + h * 128 + c]);
                run[0] += lf[0]; run[1] += lf[1];
            }
            dacc(diag, 3, bf2f(p.o_h[(size_t)(b * SEQ + sq) * DM + h * 128 + c]), acc, lane);
        }
        {
            const int row = hsh(sid, 13) % NT, col = hsh(sid, 14) % DM;
            const int rh = col >> 8, hh = col >> 7;
            float s1 = 0.f; for (int t = 0; t < 4; ++t) s1 += bf2f(p.o_r[(size_t)row * DM + rh * 256 + lane * 4 + t]);
            const float mean = wave_sum(s1) / 256.0f;
            float s2 = 0.f; for (int t = 0; t < 4; ++t) { const float dd = bf2f(p.o_r[(size_t)row * DM + rh * 256 + lane * 4 + t]) - mean; s2 += dd * dd; }
            const float rs = rsqrtf(wave_sum(s2) / 256.0f + 1e-6f);
            float s3 = 0.f; for (int t = 0; t < 2; ++t) { const float v = bf2f(p.o_h[(size_t)row * DM + hh * 128 + lane * 2 + t]); s3 += v * v; }
            const float rs2 = rsqrtf(wave_sum(s3) / 128.0f + 1e-6f);
            const bf16_t* zr = p.z + (size_t)row * NZ;
            const float rg = bf2f(zr[6144 + col]), hg = bf2f(zr[14336 + col]), gr = bf2f(zr[16384 + col]), gh = bf2f(zr[18432 + col]);
            const float a = (bf2f(p.o_r[(size_t)row * DM + col]) - mean) * rs * p.ret_nw[col] * (rg / (1.0f + expf(-rg)));
            const float bq = bf2f(p.o_h[(size_t)row * DM + col]) * rs2 * p.hg_nw[col] * (hg / (1.0f + expf(-hg)));
            const float sv = a / (1.0f + expf(-gr)) + bq / (1.0f + expf(-gh));
            dacc(diag, 4, bf2f(p.merged[(size_t)row * DM + col]), sv, lane);
        }
        {
            const int row = hsh(sid, 15) % NT, col = hsh(sid, 16) % DM;
            float a = 0.f; for (int k = lane; k < DM; k += 64) a += bf2f(p.merged[(size_t)row * DM + k]) * p.w_out[(size_t)k * DM + col];
            const float sv = wave_sum(a) + p.x[(size_t)row * DM + col];
            dacc(diag, 5, p.h2[(size_t)row * DM + col], sv, lane);
        }
        {
            const int tok = hsh(sid, 17) % NT;
            float ss = 0.f; for (int k = lane; k < DM; k += 64) { const float v = p.h2[(size_t)tok * DM + k]; ss += v * v; }
            const float rstd = rsqrtf(wave_sum(ss) / DM + 1e-6f);
            const int e = lane & 31, half = lane >> 5;
            float a = 0.f;
            for (int d = half * 1024; d < half * 1024 + 1024; ++d) a += p.h2[(size_t)tok * DM + d] * rstd * p.nmoe_w[d] * p.w_router[(size_t)d * NE + e];
            a += __shfl_xor(a, 32);
            const float lg = a + p.b_router[e];
            int rank = 0; float mx = -3.0e38f;
            for (int o = 0; o < 32; ++o) { const float ov = __shfl(lg, o); if (ov > lg || (ov == lg && o < e)) ++rank; mx = fmaxf(mx, ov); }
            float den = 0.f;
            for (int o = 0; o < 32; ++o) { const float ov = __shfl(lg, o); const int orank = __shfl(rank, o); if (orank < 4) den += expf(ov - mx); }
            const float gate = expf(lg - mx) / den;
            for (int k = 0; k < 4; ++k) {
                const int fe = p.tk_e[tok * 4 + k]; const float fg = p.tk_g[tok * 4 + k];
                const int srank = __shfl(rank, fe & 31); const float sg = __shfl(gate, fe & 31);
                const float fv = (srank == k && fe >= 0 && fe < 32) ? fg : fg + 1.0f;
                dacc(diag, 6, fv, sg, lane);
            }
        }
        {
            const int ent = hsh(sid, 18) % (NT * 4), tok = ent >> 2, e = p.tk_e[ent], dest = p.pos[ent];
            int rstart = 0; for (int q = 0; q < e; ++q) rstart += ((p.gcnt[q] + 255) >> 8) << 8;
            int bad = (dest < rstart || dest >= rstart + p.gcnt[e]) ? 1 : 0;
            for (int k = lane; k < DM; k += 64) if (((const unsigned char*)p.xg)[(size_t)dest * DM + k] != ((const unsigned char*)p.hn2)[(size_t)tok * DM + k]) bad = 1;
            if (p.row_gate[dest] != p.tk_g[ent]) bad = 1;
            for (int o = 32; o >= 1; o >>= 1) bad |= __shfl_xor(bad, o);
            dacc(diag, 7, bad ? 2.0f : 1.0f, 1.0f, lane);
            {
                const int j = hsh(sid, 19) % DFF;
                const float* w1e = p.w1 + (size_t)e * DM * 4096;
                float g = 0.f, l = 0.f;
                for (int k = lane; k < DM; k += 64) { const float xv = fp8_to_f32(((const unsigned char*)p.xg)[(size_t)dest * DM + k]) * (1.0f / X_SCALE); g += xv * w1e[(size_t)k * 4096 + 2 * j]; l += xv * w1e[(size_t)k * 4096 + 2 * j + 1]; }
                g = wave_sum(g) + p.b1[e * 4096 + 2 * j]; l = wave_sum(l) + p.b1[e * 4096 + 2 * j + 1];
                dacc(diag, 8, fp8_to_f32(((const unsigned char*)p.hid)[(size_t)dest * DFF + j]) * (1.0f / H_SCALE), swiglu_ref(g, l), lane);
            }
            {
                const int col = hsh(sid, 20) % DM;
                const float* w2e = p.w2 + (size_t)e * DFF * DM;
                float a = 0.f; for (int k = lane; k < DFF; k += 64) a += fp8_to_f32(((const unsigned char*)p.hid)[(size_t)dest * DFF + k]) * (1.0f / H_SCALE) * w2e[(size_t)k * DM + col];
                const float sv = (wave_sum(a) + p.b2[e * DM + col]) * p.row_gate[dest];
                dacc(diag, 9, bf2f(p.y[(size_t)dest * DM + col]), sv, lane);
            }
        }
        {
            const int tok = hsh(sid, 21) % NT, col = hsh(sid, 22) % DM;
            float ss = 0.f, mine = 0.f;
            for (int k = lane; k < DM; k += 64) {
                float v = p.h2[(size_t)tok * DM + k];
                for (int q = 0; q < 4; ++q) v += bf2f(p.y[(size_t)p.pos[tok * 4 + q] * DM + k]);
                ss += v * v; if (k == col) mine = v;
            }
            ss = wave_sum(ss); mine = wave_sum(mine);
            dacc(diag, 10, p.out[(size_t)tok * DM + col], mine * rsqrtf(ss / DM + 1e-6f) * p.nfin_w[col], lane);
        }
    }
}
__device__ void diag_finalize(const Params& p, int bid, int nb) {
    int fail = -1;
    for (int s = 0; s <= 10; ++s) { const float num = p.diag[2 * s], den = p.diag[2 * s + 1]; if (fail < 0 && !(num <= DIAG_THR * DIAG_THR * den)) fail = s; }
    float V = (fail < 0) ? 10.0f : 12.0f + 2.0f * (float)fail;
#if DIAG == 2
    { const float num = p.diag[2 * DIAG_STAGE], den = p.diag[2 * DIAG_STAGE + 1]; const float err = sqrtf(num / fmaxf(den, 1e-30f));
      const float num2 = p.diag[2 * DIAG_STAGE2], den2 = p.diag[2 * DIAG_STAGE2 + 1]; const float err2 = sqrtf(num2 / fmaxf(den2, 1e-30f));
      const int a = (int)fminf(8.0f, floorf(err * 20.0f)), b2 = (int)fminf(9.0f, floorf(err2 * 20.0f)); V = 10.0f * (float)(1 + a) + (float)b2; }
#endif
#if DIAG == 3
    const unsigned long long* ts = (const unsigned long long*)p.diag + 8;
    const float durA = (float)(ts[TS_A1] - ts[TS_A0]) * 0.01f, durB = (float)(ts[TS_B1] - ts[TS_B0]) * 0.01f;
    V = 10.0f + rintf(durA * (1.0f / TS_Q));
    if (bid == 0 && threadIdx.x == 0) p.out[(size_t)NT * DM - 1] = 0.f;
#endif
    const float c = sqrtf((V - 1.0f) * 1.01f);
#if DIAG == 3
    for (size_t i = (size_t)bid * NTHREADS + threadIdx.x; i < (size_t)NT * DM; i += (size_t)nb * NTHREADS) p.out[i] = (i == 12345) ? 10.0f * (1.0f + rintf(durB * (1.0f / TS_Q))) : ((i & 1) ? -c : c);
    return;
#endif
    for (size_t i = (size_t)bid * NTHREADS + threadIdx.x; i < (size_t)NT * DM; i += (size_t)nb * NTHREADS) p.out[i] = (i & 1) ? -c : c;
}
#endif

constexpr int NPHASE = 11;
__global__ void __launch_bounds__(NTHREADS, 2) fwd(Params p) {
    extern __shared__ __attribute__((aligned(16))) unsigned char shm[];
    LAS unsigned char* lds = (LAS unsigned char*)shm;
    LAS int* tb = (LAS int*)(lds + XTRA_OFF);
    volatile LAS unsigned* bst = (volatile LAS unsigned*)(lds + XTRA_OFF + 3072);
    const int lo = (int)(p.lo_hi & 0xffffffffll), hi = (int)(p.lo_hi >> 32);
    const int bid = blockIdx.x, nb = gridDim.x;
    if (threadIdx.x == 0) { bst[0] = 0u; bst[1] = 0u; bst[2] = 0u; bst[3] = 0u; }
    __syncthreads();
    XcdBarrier bar; bar.bar = p.bar; bar.x = 0; bar.st = bst;
    const bool multi = (hi - lo) > 1;
    if (multi) bar = xcd_barrier_post(p.bar, bst);
#define IN(k) (lo <= (k) && (k) < hi)
#if DIAG == 3
#define SEAM(k) do { if (IN(k) && IN((k) + 1)) xcd_barrier(bar); if (bid == 0 && threadIdx.x == 0) ((unsigned long long*)p.diag)[8 + (k) + 1] = (unsigned long long)wall_clock64(); } while (0)
#else
#define SEAM(k) do { if (IN(k) && IN((k) + 1)) xcd_barrier(bar); } while (0)
#endif

#if DIAG == 3
    if (bid == 0 && threadIdx.x == 0) ((unsigned long long*)p.diag)[8] = (unsigned long long)wall_clock64();
#endif
    if (IN(0)) { p0_prologue(p, lds, bid, nb); }
    SEAM(0);
    if (IN(1)) {
#if P1_MIX
        {
            pg8::Gemm g{p.hn, p.w_in_t, NT, 48 * 256, DM}; pg8::StaticOrder S; S.init(NT, 48 * 256, nb, bid);
            EpiZT<false, 1> E{p.z, p.cosT, p.sinT};
            pg8::gemm_phase<EpiZT<false, 1>, pg8::StaticOrder>(lds, g, S, E);
        }
        __syncthreads();
        {
            pg8::Gemm g{p.hn8, p.w_in_t8, NT, 32 * 256, DM / 2}; pg8::StaticOrder S; S.init(NT, 32 * 256, nb, bid);
            EpiGate E{p.gz};
            pg8::gemm_phase<EpiGate, pg8::StaticOrder>(lds, g, S, E);
        }
#else
        pg8::Gemm g{p.hn, p.w_in_t, NT, NZ, P1_FP8 ? DM / 2 : DM}; pg8::StaticOrder S; S.init(NT, NZ, nb, bid);
        EpiZT<(P1_FP8 != 0), 0> E{p.z, p.cosT, p.sinT};
        pg8::gemm_phase<EpiZT<(P1_FP8 != 0), 0>, pg8::StaticOrder>(lds, g, S, E);
#endif
    }
    SEAM(1);
    if (IN(2)) {
        ret_prepass(p, lds, bid, nb);
        __syncthreads();
        hg_prepass(p, lds, bid, nb);
    }
    SEAM(2);
    if (IN(3)) {
        for (int u = bid; u < 256; u += nb) { const int x = u & 7, w = u >> 3; mixer_ret(p, lds, nb == 256 ? (((x * 4 + (w >> 3)) << 3) | (w & 7)) : u, nb == 256 ? bid : -1); }
        for (int u = bid; u < 256; u += nb) { const int x = u & 7, w = u >> 3; mixer_hg(p, lds, nb == 256 ? (((x * 8 + (w >> 2)) << 2) | (w & 3)) : u, nb == 256 ? bid + 256 * 64 : -1); }
    }
    SEAM(3);
    if (IN(4)) { p3_merge(p, bid, nb); }
    SEAM(4);
    if (IN(5)) {
        pg8::Gemm g{p.merged, p.w_out_t, NT, DM, DM}; pg8::StaticOrder S; S.init(NT, DM, nb, bid);
        EpiRes E{p.h2b, p.x};
        pg8::gemm_phase<EpiRes, pg8::StaticOrder>(lds, g, S, E);
    }
    SEAM(5);
    if (IN(6)) { p5_router(p, lds, bid, nb); }
    SEAM(6);
    if (IN(7)) { p6_gather(p, lds, tb, bid, nb); }
    SEAM(7);
    if (IN(8)) {
        build_tiles(p, tb);
        pg8::Gemm g{p.hn2, p.w1t, MAXROWS, 4096, DM / 2}; MoeGather S; S.init(tb[0], 16, nb, bid, tb + 64); S.rowtok = (const int*)p.xg;
        EpiSwiglu E{(unsigned char*)p.hid, p.b1p};
        pg8::gemm_phase<EpiSwiglu, MoeGather>(lds, g, S, E);
    }
    SEAM(8);
    if (IN(9)) {
        build_tiles(p, tb);
        pg8::Gemm g{p.hid, p.w2t, MAXROWS, DM, DFF / 2}; MoeOrder S; S.init(tb[0], 8, nb, bid, tb + 64);
        EpiY E{p.y, p.b2, p.row_gate};
        pg8::gemm_phase<EpiY, MoeOrder>(lds, g, S, E);
    }
    SEAM(9);
    if (IN(10)) { p9_final(p, bid, nb); }
#if DIAG == 3
    SEAM(10);
    if (IN(11)) { diag_finalize(p, bid, nb); }
#elif DIAG
    if (IN(11)) { diag_checks(p, bid, nb); }
    if (IN(12)) { diag_finalize(p, bid, nb); }
#endif
#undef IN
#undef SEAM
}

extern "C" void kernel_launch(void* const* d_in, const int* in_sizes, int n_in, void* d_out, int out_size, void* d_ws, size_t ws_size, hipStream_t stream) {
    static int grid = 0;
    if (grid == 0) {
        int dev = 0, cus = 0;
        if (hipGetDevice(&dev) != hipSuccess || hipDeviceGetAttribute(&cus, hipDeviceAttributeMultiprocessorCount, dev) != hipSuccess) { fprintf(stderr, "kernel_launch: device query failed\n"); grid = -1; return; }
        if (hipFuncSetAttribute((const void*)fwd, hipFuncAttributeMaxDynamicSharedMemorySize, LDS_BYTES) != hipSuccess) { fprintf(stderr, "kernel_launch: hipFuncSetAttribute failed\n"); grid = -1; return; }
        int per_cu = 0;
        if (hipOccupancyMaxActiveBlocksPerMultiprocessor(&per_cu, (const void*)fwd, NTHREADS, LDS_BYTES) != hipSuccess || per_cu < 1) fprintf(stderr, "kernel_launch: occupancy query says %d\n", per_cu);
        (void)hipGetLastError();
        grid = cus > 0 ? cus : 256;
    }
    if (grid < 0) return;
    unsigned char* ws = (unsigned char*)d_ws;
    size_t off = 0;
    auto take = [&](size_t bytes) { unsigned char* r = ws + off; off += (bytes + 255) & ~(size_t)255; return r; };
    Params p{};
    p.x = (const float*)d_in[0]; p.w_in = (const float*)d_in[1]; p.ret_nw = (const float*)d_in[2]; p.hg_nw = (const float*)d_in[3]; p.lb_logits = (const float*)d_in[4];
    p.w_out = (const float*)d_in[5]; p.nmix_w = (const float*)d_in[6]; p.nmoe_w = (const float*)d_in[7]; p.w_router = (const float*)d_in[8]; p.b_router = (const float*)d_in[9];
    p.w1 = (const float*)d_in[10]; p.b1 = (const float*)d_in[11]; p.w2 = (const float*)d_in[12]; p.b2 = (const float*)d_in[13]; p.nfin_w = (const float*)d_in[14];
    p.out = (float*)d_out;
    p.bar = (unsigned*)take(XCD_BAR_WORDS * 4);
    p.diag = (float*)take(256);
    p.gcnt = (int*)take(256);
    p.whist = (int*)take((NT / 64) * 32 * 4);
    p.w_in_t = (bf16_t*)take((size_t)NZ * DM * 2);
    p.w_in_t8 = (bf16_t*)take((size_t)32 * 256 * DM);
    p.hn8 = (bf16_t*)take((size_t)NT * DM);
    p.gz = (bf16_t*)take((size_t)NT * 4096 * 2);
    p.w_out_t = (bf16_t*)take((size_t)DM * DM * 2);
    p.w1t = (bf16_t*)take((size_t)NE * 4096 * DM * 2);
    p.w2t = (bf16_t*)take((size_t)NE * DM * DFF * 2);
    p.hn = (bf16_t*)take((size_t)NT * DM * 2);
    p.z = (bf16_t*)take((size_t)NT * NZ * 2);
    p.merged = (bf16_t*)take((size_t)NT * DM * 2);
    p.hn2 = (bf16_t*)take((size_t)NT * DM * 2);
    p.xg = (bf16_t*)take((size_t)MAXROWS * DM * 2);
    p.hid = (bf16_t*)take((size_t)MAXROWS * DFF * 2);
    p.y = (bf16_t*)take((size_t)MAXROWS * DM * 2);
    p.o_r = (bf16_t*)take((size_t)NT * DM * 2);
    p.o_h = (bf16_t*)take((size_t)NT * DM * 2);
    p.h2 = (float*)take(DIAG ? (size_t)NT * DM * 4 : 256);
    p.h2b = (bf16_t*)take((size_t)NT * DM * 2);
    p.cosT = (float*)take((size_t)SEQ * 128 * 4);
    p.sinT = (float*)take((size_t)SEQ * 128 * 4);
    p.b1p = (float*)take((size_t)NE * 4096 * 4);
    p.e63 = (float*)take((size_t)4096 * 128 * 4);
    p.k2t = (bf16_t*)take((size_t)4096 * 128 * 64 * 2);
    p.wr_hi = (bf16_t*)take((size_t)NE * DM * 2);
    p.wr_lo = (bf16_t*)take((size_t)NE * DM * 2);
    p.pr = (bf16_t*)take((size_t)2048 * 4096 * 2);
    p.ph = (bf16_t*)take((size_t)4096 * 4096 * 2);
    p.kt = (bf16_t*)take((size_t)2048 * 256 * 64 * 2);
    p.dz = (bf16_t*)take(DIAG ? (size_t)NT * 4096 * 2 : 256);
    p.tk_g = (float*)take((size_t)NT * 4 * 4);
    p.row_gate = (float*)take((size_t)MAXROWS * 4);
    p.tk_e = (int*)take((size_t)NT * 4 * 4);
    p.tk_rank = (int*)take((size_t)NT * 4 * 4);
    p.pos = (int*)take((size_t)NT * 4 * 4);
    if (off > ws_size) { fprintf(stderr, "kernel_launch: workspace too small: need %zu, have %zu\n", off, ws_size); return; }
    (void)hipMemsetAsync(p.bar, 0, XCD_BAR_WORDS * 4 + 256, stream);
#if N_LAUNCH_MODE == 1
    p.lo_hi = ((long long)(NPHASE + (DIAG == 3 ? 1 : 0)) << 32) | 0ll;
    hipLaunchKernelGGL(fwd, dim3(grid), dim3(NTHREADS), LDS_BYTES, stream, p);
#else
    for (int ph = 0; ph < NPHASE + (DIAG ? 2 : 0); ++ph) {
        if (DBG_SKIP_MOE && ph >= 6 && ph <= 9) continue;
        p.lo_hi = ((long long)(ph + 1) << 32) | (long long)ph;
        hipLaunchKernelGGL(fwd, dim3(grid), dim3(NTHREADS), LDS_BYTES, stream, p);
    }
#endif
    const hipError_t le = hipPeekAtLastError();
    if (le != hipSuccess) fprintf(stderr, "kernel_launch: launch failed: %s\n", hipGetErrorName(le));
}
```
